# Optimizing an MI355X kernel written in HIP

```python
import jax, jax.numpy as jnp
from jax import lax
import numpy as np

D_MODEL = 2048
BATCH = 8
SEQ = 4096
DEPTH = 4

CTX_LEN = 256
GRID_W = 64
MIX_W = 512
N_BRANCH = 4
GROUP_DIM = 128
N_GROUPS = MIX_W // GROUP_DIM
RET_CHUNK = 128
SGU_CHUNK = 128
CONV_W = 3
D_FF = -(-8 * D_MODEL // (3 * 256)) * 256
ROPE_BASE = 10000.0
RET_DECAY_EXP0 = 5
EPS = 1e-6

Q_OFF = 0
K_OFF = MIX_W
V_OFF = 2 * MIX_W
G_OFF = 3 * MIX_W
F_OFF = 4 * MIX_W
U_OFF = 5 * MIX_W
SC_OFF = 7 * MIX_W
GATE_OFF = 10 * MIX_W
IN_W = GATE_OFF + N_BRANCH * D_MODEL

kernel_name = "hybrid_retention_fourier_sgu_conv_dit"


def rmsnorm(x, g):
    xf = x.astype(jnp.float32)
    y = xf * lax.rsqrt(jnp.mean(xf * xf, axis=-1, keepdims=True) + EPS)
    return (y * g.astype(jnp.float32)).astype(x.dtype)


def group_rms(z):
    zf = z.astype(jnp.float32)
    return zf * lax.rsqrt(jnp.mean(zf * zf, axis=-1, keepdims=True) + EPS)


def modulate(h, shift, scale):
    return h * (1 + scale) + shift


def adaln(cond, w, b):
    m = jax.nn.silu(cond) @ w + b
    return jnp.split(m, 6, axis=-1)


def _rotate(x, pos):
    n = x.shape[-1]
    freqs = ROPE_BASE ** (-jnp.arange(0, n, 2, dtype=jnp.float32) / n)
    ang = pos.astype(jnp.float32)[:, None] * freqs[None, :]
    cos = jnp.cos(ang)[:, None, :].astype(x.dtype)
    sin = jnp.sin(ang)[:, None, :].astype(x.dtype)
    x1, x2 = x[..., : n // 2], x[..., n // 2:]
    return jnp.concatenate([x1 * cos - x2 * sin, x1 * sin + x2 * cos], axis=-1)


def rope_2d(x):
    L = x.shape[1]
    t = jnp.arange(L)
    h = x.shape[-1] // 2
    return jnp.concatenate([_rotate(x[..., :h], t // GRID_W), _rotate(x[..., h:], t % GRID_W)], axis=-1)


def retention_scan(q, k, v, log_g, s0):
    Bsz, L, H, d = q.shape
    C = RET_CHUNK
    n = L // C
    lg = log_g.astype(jnp.float32)
    qc = q.reshape(Bsz, n, C, H, d)
    kc = k.reshape(Bsz, n, C, H, d)
    vc = v.reshape(Bsz, n, C, H, d)
    i = jnp.arange(C, dtype=jnp.float32)
    rel = i[:, None] - i[None, :]
    decay = jnp.where(rel >= 0, jnp.exp(lg[:, None, None] * jnp.maximum(rel, 0.0)[None]), 0.0)
    scores = jnp.einsum('bnihd,bnjhd->bnhij', qc, kc) * decay[None, None]
    inner = jnp.einsum('bnhij,bnjhd->bnihd', scores, vc)
    k_w = jnp.exp(lg[None, :] * (C - 1 - i)[:, None])
    ds = jnp.einsum('bnjhd,bnjhe->nbhde', kc * k_w[None, None, :, :, None], vc)
    chunk_decay = jnp.exp(lg * C)[None, :, None, None]

    def step(s, ds_n):
        return chunk_decay * s + ds_n, s

    _, s_prev = lax.scan(step, s0.astype(jnp.float32), ds)
    q_w = jnp.exp(lg[None, :] * (i + 1)[:, None])
    cross = jnp.einsum('bnihd,nbhde->bnihe', qc * q_w[None, None, :, :, None], s_prev)
    return (inner + cross).reshape(Bsz, L, H, d)


def retention_state(k, v, log_g):
    L = k.shape[1]
    lg = log_g.astype(jnp.float32)
    w = jnp.exp(lg[None, :] * (L - 1 - jnp.arange(L, dtype=jnp.float32))[:, None])
    return jnp.einsum('blhd,blhe->bhde', k * w[None, :, :, None], v)


def bidir_retention(q, k, v, log_g2, s0_f, s0_b):
    fwd = retention_scan(q, k, v, log_g2[0], s0_f)
    bwd = retention_scan(jnp.flip(q, 1), jnp.flip(k, 1), jnp.flip(v, 1), log_g2[1], s0_b)
    return fwd + jnp.flip(bwd, 1)


def ctx_states(kv, log_g2):
    Bsz, L, _ = kv.shape
    k = kv[..., :MIX_W].astype(jnp.float32).reshape(Bsz, L, N_GROUPS, GROUP_DIM) * GROUP_DIM ** -0.5
    v = kv[..., MIX_W:].astype(jnp.float32).reshape(Bsz, L, N_GROUPS, GROUP_DIM)
    s_f = retention_state(k, v, log_g2[0])
    s_b = retention_state(jnp.flip(k, 1), jnp.flip(v, 1), log_g2[1])
    return s_f, s_b


def fourier_mix(z):
    Bsz, L, _ = z.shape
    zg = z.astype(jnp.float32).reshape(Bsz, L, N_GROUPS, GROUP_DIM)
    y = jnp.fft.fftn(zg, axes=(1, 3), norm="ortho").real
    return y.reshape(Bsz, L, MIX_W).astype(z.dtype)


def spatial_gating(z, w_s, b_s):
    Bsz, L, _ = z.shape
    z = jax.nn.gelu(z)
    u, v = z[..., :MIX_W], z[..., MIX_W:]
    vg = v.astype(jnp.float32).reshape(Bsz, L // SGU_CHUNK, SGU_CHUNK, N_GROUPS, GROUP_DIM)
    mu = jnp.mean(vg, axis=-1, keepdims=True)
    var = jnp.mean(jnp.square(vg - mu), axis=-1, keepdims=True)
    vg = (vg - mu) * lax.rsqrt(var + EPS)
    s = jnp.einsum('bnpgc,gqp->bnqgc', vg, w_s.astype(jnp.float32)) \
        + jnp.transpose(b_s.astype(jnp.float32))[None, None, :, :, None]
    return (u.astype(jnp.float32) * s.reshape(Bsz, L, MIX_W)).astype(z.dtype)


def conv3(y, w):
    C = y.shape[-1]
    return lax.conv_general_dilated(y, w[:, None, :].astype(y.dtype), window_strides=(1,),
                                    padding=((CONV_W // 2, CONV_W // 2),),
                                    dimension_numbers=('NWC', 'WIO', 'NWC'), feature_group_count=C)


def short_conv_mix(z, w, is_latent):
    Bsz, L, _ = z.shape
    b, cg, xv = z[..., :MIX_W], z[..., MIX_W:2 * MIX_W], z[..., 2 * MIX_W:]
    y = cg * xv
    if is_latent:
        rows = L // GRID_W
        y = conv3(y.reshape(Bsz * rows, GRID_W, MIX_W), w).reshape(Bsz, L, MIX_W)
    else:
        y = conv3(y, w)
    return b * y


def token_mix(proj, log_g2, conv_w, sgu_w, sgu_b, w_branch, w_out, s0_f, s0_b, is_latent):
    Bsz, L, _ = proj.shape
    heads = lambda z: z.astype(jnp.float32).reshape(Bsz, L, N_GROUPS, GROUP_DIM)
    q = heads(proj[..., Q_OFF:Q_OFF + MIX_W])
    k = heads(proj[..., K_OFF:K_OFF + MIX_W]) * GROUP_DIM ** -0.5
    v = heads(proj[..., V_OFF:V_OFF + MIX_W])
    g = proj[..., G_OFF:G_OFF + MIX_W]
    if is_latent:
        q, k = rope_2d(q), rope_2d(k)
    ret = bidir_retention(q, k, v, log_g2, s0_f, s0_b)
    y_a = jax.nn.silu(g) * group_rms(ret).reshape(Bsz, L, MIX_W).astype(g.dtype)
    y_b = fourier_mix(proj[..., F_OFF:F_OFF + MIX_W])
    y_c = spatial_gating(proj[..., U_OFF:U_OFF + 2 * MIX_W], sgu_w, sgu_b)
    y_d = short_conv_mix(proj[..., SC_OFF:SC_OFF + 3 * MIX_W], conv_w, is_latent)
    branches = jnp.stack([y_a, y_b, y_c, y_d], axis=2).astype(proj.dtype)
    gates = jax.nn.sigmoid(proj[..., GATE_OFF:].reshape(Bsz, L, N_BRANCH, D_MODEL))
    merged = jnp.sum(gates * jnp.einsum('blnm,nmd->blnd', branches, w_branch), axis=2)
    return merged @ w_out


def swiglu(h, w1, w2):
    a = h @ w1
    return (jax.nn.silu(a[..., :D_FF]) * a[..., D_FF:]) @ w2


def setup_inputs(seed: int = 0) -> dict:
    key = jax.random.key(seed)
    ks = jax.random.split(key, 16)
    f32 = jnp.float32
    nrm = lambda k, s: jax.random.normal(k, s, f32)
    base_lg = jnp.log1p(-jnp.exp2(-(RET_DECAY_EXP0 + jnp.arange(N_GROUPS, dtype=f32))))
    return {
        "x": nrm(ks[0], (BATCH, SEQ, D_MODEL)),
        "c": nrm(ks[1], (BATCH, D_MODEL)),
        "ctx": nrm(ks[2], (BATCH, CTX_LEN, D_MODEL)),
        "c_ctx": nrm(ks[3], (D_MODEL,)),
        "ada_w": nrm(ks[4], (DEPTH, D_MODEL, 6 * D_MODEL)) * (0.5 * D_MODEL ** -0.5),
        "ada_b": nrm(ks[5], (DEPTH, 6 * D_MODEL)) * 0.01,
        "norm_g": 1.0 + 0.02 * nrm(ks[6], (DEPTH, 4, D_MODEL)),
        "w_in": nrm(ks[7], (DEPTH, D_MODEL, IN_W)) * D_MODEL ** -0.5,
        "ret_log_decay": base_lg[None, None, :] * (1.0 + 0.05 * nrm(ks[8], (DEPTH, 2, N_GROUPS))),
        "conv_w": nrm(ks[9], (DEPTH, CONV_W, MIX_W)) * CONV_W ** -0.5,
        "sgu_w": nrm(ks[10], (DEPTH, N_GROUPS, SGU_CHUNK, SGU_CHUNK)) * SGU_CHUNK ** -0.5,
        "sgu_b": 0.02 * nrm(ks[11], (DEPTH, N_GROUPS, SGU_CHUNK)),
        "w_branch": nrm(ks[12], (DEPTH, N_BRANCH, MIX_W, D_MODEL)) * MIX_W ** -0.5,
        "w_out": nrm(ks[13], (DEPTH, D_MODEL, D_MODEL)) * D_MODEL ** -0.5,
        "ffn_w_in": nrm(ks[14], (DEPTH, D_MODEL, 2 * D_FF)) * D_MODEL ** -0.5,
        "ffn_w_out": nrm(ks[15], (DEPTH, D_FF, D_MODEL)) * D_FF ** -0.5,
    }


def reference(x, c, ctx, c_ctx, ada_w, ada_b, norm_g, w_in, ret_log_decay, conv_w, sgu_w, sgu_b,
              w_branch, w_out, ffn_w_in, ffn_w_out):
    for l in range(DEPTH):
        last = l == DEPTH - 1
        sx1, cx1, gx1, sx2, cx2, gx2 = [m[:, None, :] for m in adaln(c, ada_w[l], ada_b[l])]
        sc1, cc1, gc1, sc2, cc2, gc2 = adaln(c_ctx, ada_w[l], ada_b[l])

        hc = modulate(rmsnorm(ctx, norm_g[l, 0]), sc1, cc1)
        if last:
            kv_c = hc @ w_in[l][:, K_OFF:V_OFF + MIX_W]
        else:
            proj_c = hc @ w_in[l]
            kv_c = proj_c[..., K_OFF:V_OFF + MIX_W]
        s_f, s_b = ctx_states(kv_c, ret_log_decay[l])

        hx = modulate(rmsnorm(x, norm_g[l, 0]), sx1, cx1)
        mix_x = token_mix(hx @ w_in[l], ret_log_decay[l], conv_w[l], sgu_w[l], sgu_b[l],
                          w_branch[l], w_out[l], s_f, s_b, True)
        x = x + gx1 * rmsnorm(mix_x, norm_g[l, 1])
        hx = modulate(rmsnorm(x, norm_g[l, 2]), sx2, cx2)
        x = x + gx2 * rmsnorm(swiglu(hx, ffn_w_in[l], ffn_w_out[l]), norm_g[l, 3])

        if not last:
            zero_s = jnp.zeros_like(s_f)
            mix_c = token_mix(proj_c, ret_log_decay[l], conv_w[l], sgu_w[l], sgu_b[l],
                              w_branch[l], w_out[l], zero_s, zero_s, False)
            ctx = ctx + gc1 * rmsnorm(mix_c, norm_g[l, 1])
            hc = modulate(rmsnorm(ctx, norm_g[l, 2]), sc2, cc2)
            ctx = ctx + gc2 * rmsnorm(swiglu(hc, ffn_w_in[l], ffn_w_out[l]), norm_g[l, 3])
    return x
```

```cpp
#include <hip/hip_runtime.h>
#include <cstdio>
#include <cstdint>

#ifndef PROBE_REP
#define PROBE_REP 0
#endif
#ifndef MK_PER_PHASE_LAUNCH
#define MK_PER_PHASE_LAUNCH 0
#endif

namespace pg8 {
#define PG8_LAS __attribute__((address_space(3)))
typedef unsigned short bf16_t;
typedef short bf16x8 __attribute__((ext_vector_type(8)));
typedef float f32x4 __attribute__((ext_vector_type(4)));
typedef unsigned u32x4 __attribute__((ext_vector_type(4)));
typedef int i32x4 __attribute__((ext_vector_type(4)));
constexpr int BM = 256, BK = 64, HALF = 128, HTB = HALF * BK * 2, STAGE_BYTES = 8 * HTB, NXCD = 8, WGM = 8;

__host__ __device__ __forceinline__ int lds_byte(int r, int c) { const int st = (r >> 4) * 2 + (c >> 5), rr = r & 15, cc = c & 31, ob = rr * 64 + cc * 2; return st * 1024 + (ob ^ (((ob >> 9) & 1) << 5)); }
__host__ __device__ __forceinline__ void stage_rc(int b, int& R, int& C) { const int st = b / 1024, sb = b % 1024, swz = sb ^ (((sb >> 9) & 1) << 5); R = (st >> 1) * 16 + swz / 64; C = (st & 1) * 32 + (swz % 64) / 2; }
__host__ __device__ __forceinline__ int perm32(int rho) { const int n = rho >> 4, i = rho & 15; return 8 * (i >> 2) + 4 * n + (i & 3); }

struct Unit { int row0, col0, z, nt; const char* a; const char* b; };
struct Gemm { int lda, ldb, K; };

template <int nM, int nN> __device__ __forceinline__ void map_tile(int wgid, int& pm, int& pn) {
    constexpr int nwg = nM * nN;
    { constexpr int q = nwg / NXCD, r = nwg % NXCD; const int xcd = wgid % NXCD, off = wgid / NXCD; wgid = (xcd < r ? xcd * (q + 1) : r * (q + 1) + (xcd - r) * q) + off; }
    constexpr int nig = WGM * nN; const int gid = wgid / nig, fm = gid * WGM, gsz = (nM - fm) < WGM ? (nM - fm) : WGM;
    pm = fm + ((wgid % nig) % gsz); pn = (wgid % nig) / gsz;
}

typedef float cvt_f32x2 __attribute__((ext_vector_type(2)));
typedef __bf16 cvt_bf16x2 __attribute__((ext_vector_type(2)));
__device__ __forceinline__ unsigned cvt_pk_bf16(float lo, float hi) { const cvt_f32x2 v = {lo, hi}; const cvt_bf16x2 b = __builtin_convertvector(v, cvt_bf16x2); return __builtin_bit_cast(unsigned, b); }

template <class Epi, class Sched, bool ALIGN_EPI = false, bool SP2 = false, bool RELAX = false, bool FP8 = false, bool BLKB = false, bool BLKA = false>
__device__ __forceinline__ void gemm_phase(PG8_LAS unsigned char* lds, const Gemm g, const Sched& S, const Epi& E, const int wave_id) {
    unsigned m_ = ~0u; asm volatile("" : "+s"(m_)); int lane_ = (int)__builtin_amdgcn_mbcnt_hi(m_, __builtin_amdgcn_mbcnt_lo(m_, 0u));
    const int wid = wave_id, lane = lane_, tid = wid * 64 + lane, wr = wid >> 2, wc = wid & 3, fr = lane & 15, fq = lane >> 4;
    unsigned voffA[2], voffB[2];
#pragma unroll
    for (int i = 0; i < 2; ++i) { int R, C; stage_rc(tid * 16 + i * 8192, R, C); const int Rb = (R & ~31) + perm32(R & 31);
        voffA[i] = BLKA ? (unsigned)(((R >> 4) * ((g.lda * 2) >> 6) + ((C * 2) >> 6)) * 1024 + (R & 15) * 64 + ((C * 2) & 63)) : (unsigned)(R * g.lda + C) * 2u;
        voffB[i] = BLKB ? (unsigned)(((R >> 4) * ((g.ldb * 2) >> 6) + ((C * 2) >> 6)) * 1024 + (R & 15) * 64 + ((C * 2) & 63)) : (unsigned)(Rb * g.ldb + C) * 2u; }
    const size_t kstep = BLKA ? (size_t)2048 : (size_t)(BK * 2), kstepB = BLKB ? (size_t)2048 : (size_t)(BK * 2);
    const size_t hstepA = (size_t)HALF * g.lda * 2, hstepB = (size_t)HALF * g.ldb * 2;
    const unsigned ldsw = (unsigned)wid * 1024u;
    const int aoff = lds_byte(wr * 64 + fr, fq * 8), boff = lds_byte(wc * 32 + fr, fq * 8);
#define PG8_SA(b, h) (((b) * 2 + (h)) * HTB)
#define PG8_SB(b, h) ((4 + (b) * 2 + (h)) * HTB)
#define PG8_STAGE(bufoff, gbase, voff) do { _Pragma("unroll") for (int _i = 0; _i < 2; ++_i) \
        __builtin_amdgcn_global_load_lds((const unsigned*)((const char*)(gbase) + (voff)[_i]), (PG8_LAS unsigned*)(lds + (bufoff) + ldsw + _i * 8192), 16, 0, 0); } while (0)
#define PG8_LDA(dst, b, h) do { _Pragma("unroll") for (int m = 0; m < 4; ++m) _Pragma("unroll") for (int k = 0; k < 2; ++k) dst[m][k] = *(const PG8_LAS bf16x8*)(lds + PG8_SA(b, h) + aoff + m * 2048 + k * 1024); } while (0)
#define PG8_LDB(dst, b, h) do { _Pragma("unroll") for (int n = 0; n < 2; ++n) _Pragma("unroll") for (int k = 0; k < 2; ++k) dst[n][k] = *(const PG8_LAS bf16x8*)(lds + PG8_SB(b, h) + boff + n * 2048 + k * 1024); } while (0)
#define PG8_CAT8(x) __builtin_shufflevector(__builtin_bit_cast(i32x4, x[0]), __builtin_bit_cast(i32x4, x[1]), 0, 1, 2, 3, 4, 5, 6, 7)
#define PG8_MMA(ai, bj, At, Bt) do { __builtin_amdgcn_s_setprio(1); \
        if constexpr (FP8) { _Pragma("unroll") for (int m = 0; m < 4; ++m) _Pragma("unroll") for (int n = 0; n < 2; ++n) \
            asm volatile("v_mfma_f32_16x16x128_f8f6f4 %0, %1, %2, %0" : "+v"(acc[ai][bj][m][n]) : "v"(PG8_CAT8(Bt[n])), "v"(PG8_CAT8(At[m]))); } \
        else { _Pragma("unroll") for (int m = 0; m < 4; ++m) _Pragma("unroll") for (int n = 0; n < 2; ++n) _Pragma("unroll") for (int k = 0; k < 2; ++k) \
            acc[ai][bj][m][n] = __builtin_amdgcn_mfma_f32_16x16x32_bf16(Bt[n][k], At[m][k], acc[ai][bj][m][n], 0, 0, 0); } \
        __builtin_amdgcn_s_setprio(0); } while (0)
#define PG8_WAIT_V(n) asm volatile("s_waitcnt vmcnt(" #n ")" ::: "memory")
#define PG8_WAIT_L(n) asm volatile("s_waitcnt lgkmcnt(" #n ")" ::: "memory")
#define PG8_WAIT_VR() do { if constexpr (RELAX && Epi::NSTORE >= 16) asm volatile("s_cmp_eq_u32 %0, 0\n\ts_cbranch_scc1 1f\n\ts_waitcnt vmcnt(24)\n\ts_branch 2f\n1:\n\ts_waitcnt vmcnt(8)\n2:" :: "s"(rlx) : "scc", "memory"); \
        else if constexpr (RELAX && Epi::NSTORE >= 8) asm volatile("s_cmp_eq_u32 %0, 0\n\ts_cbranch_scc1 1f\n\ts_waitcnt vmcnt(16)\n\ts_branch 2f\n1:\n\ts_waitcnt vmcnt(8)\n2:" :: "s"(rlx) : "scc", "memory"); \
        else PG8_WAIT_V(8); } while (0)
#define PG8_BAR __builtin_amdgcn_s_barrier()
#define PG8_SCHED __builtin_amdgcn_sched_barrier(0)
    Unit cur, nxt; int ui = 0; int pre = 0;
    if (!S.next(0, cur)) return;
    f32x4 acc[2][2][4][2];
#pragma unroll
    for (int a = 0; a < 2; ++a)
#pragma unroll
        for (int b = 0; b < 2; ++b)
#pragma unroll
            for (int m = 0; m < 4; ++m)
#pragma unroll
                for (int n = 0; n < 2; ++n) acc[a][b][m][n] = (f32x4){0.f, 0.f, 0.f, 0.f};
    bf16x8 At[4][2], B0[2][2], B1[2][2];
    const char* cA = cur.a; const char* cB = cur.b;
    if constexpr (SP2) {
        PG8_STAGE(PG8_SB(0, 0), cB, voffB); PG8_STAGE(PG8_SB(0, 1), cB + hstepB, voffB); PG8_STAGE(PG8_SA(0, 0), cA, voffA); PG8_STAGE(PG8_SA(0, 1), cA + hstepA, voffA);
        if (wr == 1) PG8_BAR;
        PG8_WAIT_V(2); PG8_BAR;
        PG8_STAGE(PG8_SB(1, 0), cB + kstepB, voffB); PG8_STAGE(PG8_SA(1, 0), cA + kstep, voffA); PG8_STAGE(PG8_SB(1, 1), cB + hstepB + kstepB, voffB);
        PG8_WAIT_V(6); PG8_BAR;
    } else {
        PG8_STAGE(PG8_SB(0, 0), cB, voffB); PG8_STAGE(PG8_SA(0, 0), cA, voffA); PG8_STAGE(PG8_SB(0, 1), cB + hstepB, voffB); PG8_STAGE(PG8_SA(0, 1), cA + hstepA, voffA);
        if (wr == 1) PG8_BAR;
        PG8_WAIT_V(4); PG8_BAR;
        PG8_STAGE(PG8_SB(1, 0), cB + kstepB, voffB); PG8_STAGE(PG8_SA(1, 0), cA + kstep, voffA); PG8_STAGE(PG8_SB(1, 1), cB + hstepB + kstepB, voffB);
        PG8_WAIT_V(6); PG8_BAR;
    }
    for (;;) {
        const bool has_next = S.next(ui + 1, nxt);
        const char* nA = has_next ? nxt.a : cA; const char* nB = has_next ? nxt.b : cB;
        const int nt = cur.nt;
        for (int t = 0; t < nt; t += 2) {
            const bool last = (t == nt - 2);
            const char* a1 = cA + (size_t)(t + 1) * kstep;
            const char* a2 = last ? nA : cA + (size_t)(t + 2) * kstep; const char* b2 = last ? nB : cB + (size_t)(t + 2) * kstepB;
            const char* a3 = a2 + kstep; const char* b3 = b2 + kstepB;
            if constexpr (SP2) {
            const int rlx = (t == 0) ? pre : 0;
            PG8_LDB(B0, 0, 0); PG8_LDB(B1, 0, 1); PG8_SCHED; PG8_LDA(At, 0, 0); PG8_STAGE(PG8_SA(1, 1), a1 + hstepA, voffA);
            PG8_WAIT_VR(); PG8_WAIT_L(0); PG8_BAR; PG8_MMA(0, 0, At, B0); PG8_MMA(0, 1, At, B1); PG8_BAR; PG8_SCHED;
            PG8_LDA(At, 0, 1); PG8_STAGE(PG8_SB(0, 0), b2, voffB); PG8_STAGE(PG8_SB(0, 1), b2 + hstepB, voffB); PG8_STAGE(PG8_SA(0, 0), a2, voffA);
            PG8_WAIT_VR(); PG8_WAIT_L(0); PG8_BAR; PG8_MMA(1, 0, At, B0); PG8_MMA(1, 1, At, B1); PG8_BAR; PG8_SCHED;
            PG8_LDB(B0, 1, 0); PG8_LDB(B1, 1, 1); PG8_SCHED; PG8_LDA(At, 1, 0); PG8_STAGE(PG8_SA(0, 1), a2 + hstepA, voffA);
            PG8_WAIT_V(8); PG8_WAIT_L(0); PG8_BAR; PG8_MMA(0, 0, At, B0); PG8_MMA(0, 1, At, B1); PG8_BAR; PG8_SCHED;
            PG8_LDA(At, 1, 1); PG8_STAGE(PG8_SB(1, 0), b3, voffB); PG8_STAGE(PG8_SB(1, 1), b3 + hstepB, voffB); PG8_STAGE(PG8_SA(1, 0), a3, voffA);
            PG8_WAIT_V(8); PG8_WAIT_L(0); PG8_BAR; PG8_MMA(1, 0, At, B0); PG8_MMA(1, 1, At, B1); PG8_BAR; PG8_SCHED;
            } else {
            PG8_LDB(B0, 0, 0); PG8_SCHED; PG8_LDA(At, 0, 0); PG8_STAGE(PG8_SA(1, 1), a1 + hstepA, voffA);
            PG8_WAIT_L(8); PG8_BAR; PG8_WAIT_L(0); PG8_MMA(0, 0, At, B0); PG8_BAR; PG8_SCHED;
            PG8_LDB(B1, 0, 1); PG8_STAGE(PG8_SB(0, 0), b2, voffB);
            PG8_BAR; PG8_WAIT_L(0); PG8_MMA(0, 1, At, B1); PG8_BAR;
            PG8_LDA(At, 0, 1); PG8_STAGE(PG8_SA(0, 0), a2, voffA);
            PG8_BAR; PG8_WAIT_L(0); PG8_MMA(1, 0, At, B0); PG8_BAR; PG8_SCHED;
            PG8_STAGE(PG8_SB(0, 1), b2 + hstepB, voffB);
            PG8_WAIT_V(6); PG8_BAR; PG8_MMA(1, 1, At, B1); PG8_BAR;
            PG8_LDB(B0, 1, 0); PG8_SCHED; PG8_LDA(At, 1, 0); PG8_STAGE(PG8_SA(0, 1), a2 + hstepA, voffA);
            PG8_WAIT_L(8); PG8_BAR; PG8_WAIT_L(0); PG8_MMA(0, 0, At, B0); PG8_BAR; PG8_SCHED;
            PG8_LDB(B1, 1, 1); PG8_STAGE(PG8_SB(1, 0), b3, voffB);
            PG8_BAR; PG8_WAIT_L(0); PG8_MMA(0, 1, At, B1); PG8_BAR;
            PG8_LDA(At, 1, 1); PG8_STAGE(PG8_SA(1, 0), a3, voffA);
            PG8_BAR; PG8_WAIT_L(0); PG8_MMA(1, 0, At, B0); PG8_BAR; PG8_SCHED;
            PG8_STAGE(PG8_SB(1, 1), b3 + hstepB, voffB);
            PG8_WAIT_V(6); PG8_BAR; PG8_MMA(1, 1, At, B1); PG8_BAR;
            }
        }
        if constexpr (ALIGN_EPI) { if (wr == 0) PG8_BAR; }
        if constexpr (RELAX && SP2 && Epi::NSTORE >= 8) pre = 1;
        if constexpr (Epi::CHAIN) {
            const bool keep = E.chain(acc, cur, wr, wc);
            if (!has_next) break;
            if (!keep) {
#pragma unroll
                for (int a = 0; a < 2; ++a)
#pragma unroll
                    for (int b = 0; b < 2; ++b)
#pragma unroll
                        for (int m = 0; m < 4; ++m)
#pragma unroll
                            for (int n = 0; n < 2; ++n) acc[a][b][m][n] = (f32x4){0.f, 0.f, 0.f, 0.f};
            }
        } else {
        E(acc, cur, wr, wc);
        if (!has_next) break;
#pragma unroll
        for (int a = 0; a < 2; ++a)
#pragma unroll
            for (int b = 0; b < 2; ++b)
#pragma unroll
                for (int m = 0; m < 4; ++m)
#pragma unroll
                    for (int n = 0; n < 2; ++n) acc[a][b][m][n] = (f32x4){0.f, 0.f, 0.f, 0.f};
        }
        cur = nxt; cA = nA; cB = nB; ++ui;
        if constexpr (ALIGN_EPI) { if (wr == 1) PG8_BAR; }
    }
    PG8_WAIT_V(0);
    if constexpr (!ALIGN_EPI) { if (wr == 0) PG8_BAR; }
    PG8_BAR;
#undef PG8_SA
#undef PG8_SB
#undef PG8_STAGE
#undef PG8_LDA
#undef PG8_LDB
#undef PG8_MMA
#undef PG8_CAT8
#undef PG8_WAIT_V
#undef PG8_WAIT_L
#undef PG8_WAIT_VR
#undef PG8_BAR
#undef PG8_SCHED
}
}

constexpr int DM = 2048, NB = 8, SEQ = 4096, CTXL = 256, DEPTH = 4, MIXW = 512, GD = 128, NGRP = 4;
constexpr int INW = 13312, DFF = 5632, ADAW = 6 * DM, NCOND = NB + 1;
constexpr int RL = NB * SEQ, RC = NB * CTXL, RT = RL + RC;
constexpr int Q_OFF = 0, K_OFF = 512, V_OFF = 1024, G_OFF = 1536, F_OFF = 2048, U_OFF = 2560, VS_OFF = 3072, SCB_OFF = 3584, SCC_OFF = 4096, SCX_OFF = 4608, GATE_OFF = 5120;
constexpr int NCH = 34;
constexpr float EPS = 1e-6f;
constexpr int NWAVES = 8, NTHR = 512;

constexpr size_t MiB = 1u << 20;
constexpr size_t WS_CTL = 0, CTL_ZERO_BYTES = 1 * MiB;
constexpr size_t WS_MOD = 1 * MiB;
constexpr size_t WS_MODP = 3 * MiB;
constexpr size_t WS_TAB = 17 * MiB;
constexpr size_t WS_DFTC = 18 * MiB;
constexpr size_t WS_DFTL = 19 * MiB;
constexpr size_t WS_XC = 83 * MiB;
constexpr size_t WS_WIN = 99 * MiB;
constexpr size_t WS_WBR = 151 * MiB;
constexpr size_t WS_WOUT = 159 * MiB;
constexpr size_t WS_W1 = 167 * MiB;
constexpr size_t WS_W2 = 211 * MiB;
constexpr size_t WS_BUFA = 233 * MiB;
constexpr size_t WS_BUFB = 369 * MiB;
constexpr size_t WS_ZCT = 505 * MiB;
constexpr size_t WS_ST = 573 * MiB;
constexpr size_t WS_PROJ = 641 * MiB;
constexpr size_t WS_HX8 = 1525 * MiB;
constexpr size_t WS_END = 1593 * MiB;
static_assert(WS_PROJ + (size_t)RT * INW * 2 <= WS_END, "ws map");
static_assert((size_t)NB * NGRP * 2 * NCH * GD * GD * 4 <= WS_BUFB - WS_BUFA, "DS overlay fits BUFA");
static_assert((size_t)NB * NGRP * 2 * NCH * GD * GD * 2 <= WS_PROJ - WS_ST, "states");

constexpr int CW_TMO = 0;
constexpr int CW_BAR = 4096;

constexpr int SCR_BYTES = 155648;
constexpr int MISC_OFF = SCR_BYTES;
constexpr int LDS_BYTES = SCR_BYTES + 1024;

#define GAS __attribute__((address_space(1)))
#define LAS __attribute__((address_space(3)))
typedef unsigned short bf16;
typedef float f32x4 __attribute__((ext_vector_type(4)));
typedef float f32x2 __attribute__((ext_vector_type(2)));
typedef unsigned u32x4 __attribute__((ext_vector_type(4)));
typedef unsigned u32x2 __attribute__((ext_vector_type(2)));

__device__ __forceinline__ unsigned f2bf(float f) { unsigned u = __builtin_bit_cast(unsigned, f); return (u + 0x7fffu + ((u >> 16) & 1u)) >> 16; }
__device__ __forceinline__ unsigned pk2(float lo, float hi) { return pg8::cvt_pk_bf16(lo, hi); }
__device__ __forceinline__ float bflo(unsigned w) { return __builtin_bit_cast(float, w << 16); }
__device__ __forceinline__ float bfhi(unsigned w) { return __builtin_bit_cast(float, w & 0xffff0000u); }
__device__ __forceinline__ float bf1(unsigned short h) { return __builtin_bit_cast(float, (unsigned)h << 16); }
__device__ __forceinline__ float sigmoid_f(float x) { return __builtin_amdgcn_rcpf(1.f + __expf(-x)); }
__device__ __forceinline__ float silu_f(float x) { return x * sigmoid_f(x); }
__device__ __forceinline__ float gelu_tanh_f(float x) { const float u = 0.7978845608028654f * (x + 0.044715f * x * x * x); return x * sigmoid_f(2.f * u); }

#define XB_TMO      128
#define XB_XCNT(j)  (256  + 64 * (j))
#define XB_XSUB(j)  (1280 + 64 * (j))
#define XB_XGEN(j)  (2304 + 64 * (j))
#define XB_TOP      3328
#define XB_TOPGEN   3392
#define XCD_BAR_WORDS 3456
#define XB_SPIN_CAP (1u << 18)
__device__ __forceinline__ unsigned xb_ld(unsigned* p)              { return __hip_atomic_load(p, __ATOMIC_RELAXED, __HIP_MEMORY_SCOPE_AGENT); }
__device__ __forceinline__ unsigned xb_add(unsigned* p, unsigned v) { return __hip_atomic_fetch_add(p, v, __ATOMIC_RELAXED, __HIP_MEMORY_SCOPE_AGENT); }
__device__ __forceinline__ unsigned xb_xcc_id() { return (unsigned)__builtin_amdgcn_s_getreg((3 << 11) | 20) & 0xFu; }
#define XB_SPIN(cond, bar) do { unsigned _sp = 0; while (cond) { __builtin_amdgcn_s_sleep(1); \
    if ((++_sp & 255u) == 0u) { if (xb_ld(&(bar)[XB_TMO])) break; if (_sp > XB_SPIN_CAP) { atomicAdd(&(bar)[XB_TMO], 1u); break; } } } } while (0)
struct XcdBarrier { unsigned* bar; unsigned x; volatile LAS unsigned* st; };
__device__ __forceinline__ XcdBarrier xcd_barrier_post(unsigned* bar, volatile LAS unsigned* st) {
    XcdBarrier b; b.bar = bar; b.x = xb_xcc_id(); b.st = st;
    if (threadIdx.x == 0) (void)xb_add(&bar[XB_XCNT(b.x)], 1u);
    return b;
}
__device__ __forceinline__ void xcd_barrier_complete(unsigned* bar, unsigned x, unsigned& nloc, unsigned& nx) {
    const unsigned G = gridDim.x * gridDim.y * gridDim.z;
    unsigned sum, cnt, mine, sp = 0u;
    for (;;) {
        sum = 0u; cnt = 0u; mine = 0u;
#pragma unroll
        for (unsigned j = 0; j < 16; ++j) { const unsigned c = xb_ld(&bar[XB_XCNT(j)]); sum += c; cnt += (c > 0u) ? 1u : 0u; mine = (j == x) ? c : mine; }
        if (sum == G) break;
        __builtin_amdgcn_s_sleep(1);
        if ((++sp & 255u) == 0u) { if (xb_ld(&bar[XB_TMO])) break; if (sp > XB_SPIN_CAP) { atomicAdd(&bar[XB_TMO], 1u); break; } }
    }
    nloc = mine > 0u ? mine : 1u; nx = cnt > 0u ? cnt : 1u;
}
__device__ __forceinline__ void xcd_barrier(const XcdBarrier& b, const bool leader  ) {
    asm volatile("s_waitcnt vmcnt(0)" ::: "memory");
    __syncthreads();
    if (leader) {
        unsigned* bar = b.bar;
        __builtin_amdgcn_s_waitcnt(0);
        unsigned nloc = b.st[0], nx = b.st[1];
        if (nloc == 0u) { xcd_barrier_complete(bar, b.x, nloc, nx); b.st[0] = nloc; b.st[1] = nx; }
        const unsigned old = xb_add(&bar[XB_XSUB(b.x)], 1u);
        const unsigned gen = old / nloc;
        if (old + 1u == (gen + 1u) * nloc) {
            __builtin_amdgcn_fence(__ATOMIC_RELEASE, "agent");
            asm volatile("s_waitcnt vmcnt(0)" ::: "memory");
            const unsigned og = xb_add(&bar[XB_TOP], 1u);
            const unsigned tg = og / nx;
            if (og + 1u == (tg + 1u) * nx) xb_add(&bar[XB_TOPGEN], 1u);
            else XB_SPIN(xb_ld(&bar[XB_TOPGEN]) == tg, bar);
            __builtin_amdgcn_fence(__ATOMIC_ACQUIRE, "agent");
            xb_add(&bar[XB_XGEN(b.x)], 1u);
            asm volatile("s_waitcnt vmcnt(0)" ::: "memory");
        } else {
            XB_SPIN(xb_ld(&bar[XB_XGEN(b.x)]) == gen, bar);
            __builtin_amdgcn_fence(__ATOMIC_ACQUIRE, "agent");
            asm volatile("s_waitcnt vmcnt(0)" ::: "memory");
        }
    }
    __syncthreads();
}

using pg8::Unit; using pg8::cvt_pk_bf16;
__device__ __forceinline__ u32x4 pack8(const f32x4 v0, const f32x4 v1) { u32x4 w; w.x = cvt_pk_bf16(v0[0], v0[1]); w.y = cvt_pk_bf16(v0[2], v0[3]); w.z = cvt_pk_bf16(v1[0], v1[1]); w.w = cvt_pk_bf16(v1[2], v1[3]); return w; }

struct EpiProj {
    static constexpr bool CHAIN = false; static constexpr int NSTORE = 16;
    bf16* O; const float* rope; float gsc;
    __device__ __forceinline__ void operator()(const f32x4 (&acc)[2][2][4][2], const Unit& u, int wr, int wc) const {
        unsigned em_ = ~0u; asm volatile("" : "+s"(em_)); const int el_ = (int)__builtin_amdgcn_mbcnt_hi(em_, __builtin_amdgcn_mbcnt_lo(em_, 0u)); const int fr = el_ & 15, fq = el_ >> 4;
        const int col0 = u.col0; const bool ctx = u.row0 >= RL;
        int act;
        if (col0 < K_OFF) act = ctx ? 0 : 4; else if (col0 < V_OFF) act = ctx ? 6 : 5; else if (col0 < G_OFF) act = 0; else if (col0 < F_OFF) act = 1;
        else if (col0 < U_OFF) act = 0; else if (col0 < SCB_OFF) act = 2; else if (col0 < GATE_OFF) act = 0; else act = 3;
        const float ksc = (act == 5 || act == 6) ? 0.08838834764831845f : 1.f;
        const int rowb = u.row0 + wr * 64 + fr, colb = col0 + wc * 32 + 8 * fq;
        if (act == 3) {
            const float nsc = -1.4426950408889634f * gsc;
            const int pg = (col0 - GATE_OFF) >> 8, pn_c = pg >> 2, bj_c = (pg >> 1) & 1, w_c = wr * 4 + ((pg & 1) << 1) + (wc >> 1), lane_c = fr + 16 * (2 * (wc & 1) + (fq & 1));
            const int slot0 = u.row0 + 32 * pn_c + w_c + ((fq >> 1) ? 8 : 0);
#pragma unroll
            for (int ai = 0; ai < 2; ++ai)
#pragma unroll
                for (int m = 0; m < 4; ++m) {
                    bf16* rowp = O + (size_t)slot0 * INW + GATE_OFF + (((ai * 4 + m) * 2 + bj_c) * 64 + lane_c) * 8;
                    unsigned ow[4][2];
#pragma unroll
                    for (int hp = 0; hp < 2; ++hp) {
                        float t[4][2], r[4][2];
#pragma unroll
                        for (int gn = 0; gn < 4; ++gn)
#pragma unroll
                            for (int e = 0; e < 2; ++e) { t[gn][e] = 1.f + __builtin_amdgcn_exp2f(fminf(acc[ai][gn >> 1][m][gn & 1][2 * hp + e] * nsc, 86.5617f)); r[gn][e] = __builtin_amdgcn_rcpf(t[gn][e]); }
#pragma unroll
                        for (int gn = 0; gn < 4; ++gn) ow[gn][hp] = (gn < 3) ? cvt_pk_bf16(t[gn + 1 > 3 ? 3 : gn + 1][0] * r[gn][0], t[gn + 1 > 3 ? 3 : gn + 1][1] * r[gn][1]) : cvt_pk_bf16(r[3][0], r[3][1]);
                    }
#pragma unroll
                    for (int pr = 0; pr < 4; pr += 2) {
                        const auto sx = __builtin_amdgcn_permlane32_swap(ow[pr][0], ow[pr + 1][0], false, false);
                        const auto sy = __builtin_amdgcn_permlane32_swap(ow[pr][1], ow[pr + 1][1], false, false);
                        u32x4 o; o.x = sx[0]; o.y = sy[0]; o.z = sx[1]; o.w = sy[1];
                        *(u32x4*)(rowp + (size_t)(8 * pr) * INW) = o; }
                    __builtin_amdgcn_sched_barrier(0);
                }
            return;
        }
        const bool hi = fr >= 8;
#pragma unroll
        for (int ai = 0; ai < 2; ++ai)
#pragma unroll
            for (int m = 0; m < 4; ++m) {
                const int rowg = u.row0 + wr * 64 + ai * 128 + m * 16, row = rowg + fr;
                u32x4 w[2];
#pragma unroll
                for (int bj = 0; bj < 2; ++bj) {
                    f32x4 v0 = acc[ai][bj][m][0], v1 = acc[ai][bj][m][1];
                    if (act == 1) {
#pragma unroll
                        for (int e = 0; e < 4; ++e) { v0[e] = silu_f(v0[e]); v1[e] = silu_f(v1[e]); }
                    } else if (act == 2) {
#pragma unroll
                        for (int e = 0; e < 4; ++e) { v0[e] = gelu_tanh_f(v0[e]); v1[e] = gelu_tanh_f(v1[e]); }
                    } else if (act == 4 || act == 5) {
                        const int t = row & (SEQ - 1); const int pos = (wc & 1) ? (t & 63) : (t >> 6); const int j0 = 16 * bj + 4 * fq;
                        const f32x4* rp = (const f32x4*)(rope + (size_t)(pos * 32 + j0) * 2); const f32x4 cs0 = rp[0], cs1 = rp[1];
                        f32x4 o0, o1;
                        o0[0] = v0[0] * cs0[0] - v0[1] * cs0[1]; o0[1] = v0[0] * cs0[1] + v0[1] * cs0[0];
                        o0[2] = v0[2] * cs0[2] - v0[3] * cs0[3]; o0[3] = v0[2] * cs0[3] + v0[3] * cs0[2];
                        o1[0] = v1[0] * cs1[0] - v1[1] * cs1[1]; o1[1] = v1[0] * cs1[1] + v1[1] * cs1[0];
                        o1[2] = v1[2] * cs1[2] - v1[3] * cs1[3]; o1[3] = v1[2] * cs1[3] + v1[3] * cs1[2];
                        v0 = o0 * ksc; v1 = o1 * ksc;
                    } else if (act == 6) { v0 = v0 * ksc; v1 = v1 * ksc; }
                    w[bj] = pack8(v0, v1);
                }
                u32x4 snd, rcv, d1, d2;
                snd.x = hi ? w[0].x : w[1].x; snd.y = hi ? w[0].y : w[1].y; snd.z = hi ? w[0].z : w[1].z; snd.w = hi ? w[0].w : w[1].w;
                rcv.x = (unsigned)__builtin_amdgcn_update_dpp(0, (int)snd.x, 0x128, 0xf, 0xf, false); rcv.y = (unsigned)__builtin_amdgcn_update_dpp(0, (int)snd.y, 0x128, 0xf, 0xf, false);
                rcv.z = (unsigned)__builtin_amdgcn_update_dpp(0, (int)snd.z, 0x128, 0xf, 0xf, false); rcv.w = (unsigned)__builtin_amdgcn_update_dpp(0, (int)snd.w, 0x128, 0xf, 0xf, false);
                d1.x = hi ? rcv.x : w[0].x; d1.y = hi ? rcv.y : w[0].y; d1.z = hi ? rcv.z : w[0].z; d1.w = hi ? rcv.w : w[0].w;
                d2.x = hi ? w[1].x : rcv.x; d2.y = hi ? w[1].y : rcv.y; d2.z = hi ? w[1].z : rcv.z; d2.w = hi ? w[1].w : rcv.w;
                bf16* p1 = O + (size_t)(rowg + (fr & 7)) * INW + col0 + wc * 64 + (hi ? 32 : 0) + 8 * fq;
                *(u32x4*)p1 = d1; *(u32x4*)(p1 + (size_t)8 * INW) = d2;
            }
    }
};
__device__ __forceinline__ size_t ablk(int r, int c, int K) { return ((size_t)(r >> 4) * (K >> 5) + (c >> 5)) * 1024 + (r & 15) * 64 + (c & 31) * 2; }
template <bool FL> struct EpiPlainT {
    static constexpr bool CHAIN = false; static constexpr int NSTORE = 16;
    bf16* O; int ldc; float scale; float* part;
    __device__ __forceinline__ void operator()(const f32x4 (&acc)[2][2][4][2], const Unit& u, int wr, int wc) const {
        unsigned em_ = ~0u; asm volatile("" : "+s"(em_)); const int el_ = (int)__builtin_amdgcn_mbcnt_hi(em_, __builtin_amdgcn_mbcnt_lo(em_, 0u)); const int fr = el_ & 15, fq = el_ >> 4;
        const int rowb = u.row0 + wr * 64 + fr, colb = u.col0 + (FL ? wc * 64 : wc * 32) + 8 * fq; constexpr int BJS = FL ? 32 : 128;
        if (u.z > 0) {
            float* pb = part + ((size_t)(u.z - 1) * RC + (rowb - RL)) * DM + colb;
#pragma unroll
            for (int ai = 0; ai < 2; ++ai)
#pragma unroll
                for (int m = 0; m < 4; ++m) { float* rowp = pb + (size_t)(ai * 128 + m * 16) * DM;
#pragma unroll
                    for (int bj = 0; bj < 2; ++bj) { *(f32x4*)(rowp + bj * BJS) = acc[ai][bj][m][0]; *(f32x4*)(rowp + bj * BJS + 4) = acc[ai][bj][m][1]; } }
            return;
        }
        if (FL) {
            const bool hi = fr >= 8;
#pragma unroll
            for (int ai = 0; ai < 2; ++ai)
#pragma unroll
                for (int m = 0; m < 4; ++m) {
                    const u32x4 w0 = pack8(acc[ai][0][m][0] * scale, acc[ai][0][m][1] * scale), w1 = pack8(acc[ai][1][m][0] * scale, acc[ai][1][m][1] * scale);
                    u32x4 snd, rcv, d1, d2;
                    snd.x = hi ? w0.x : w1.x; snd.y = hi ? w0.y : w1.y; snd.z = hi ? w0.z : w1.z; snd.w = hi ? w0.w : w1.w;
                    rcv.x = (unsigned)__builtin_amdgcn_update_dpp(0, (int)snd.x, 0x128, 0xf, 0xf, false); rcv.y = (unsigned)__builtin_amdgcn_update_dpp(0, (int)snd.y, 0x128, 0xf, 0xf, false);
                    rcv.z = (unsigned)__builtin_amdgcn_update_dpp(0, (int)snd.z, 0x128, 0xf, 0xf, false); rcv.w = (unsigned)__builtin_amdgcn_update_dpp(0, (int)snd.w, 0x128, 0xf, 0xf, false);
                    d1.x = hi ? rcv.x : w0.x; d1.y = hi ? rcv.y : w0.y; d1.z = hi ? rcv.z : w0.z; d1.w = hi ? rcv.w : w0.w;
                    d2.x = hi ? w1.x : rcv.x; d2.y = hi ? w1.y : rcv.y; d2.z = hi ? w1.z : rcv.z; d2.w = hi ? w1.w : rcv.w;
                    bf16* p1 = O + (size_t)(u.row0 + wr * 64 + ai * 128 + m * 16 + (fr & 7)) * ldc + colb + (hi ? 32 : 0);
                    *(u32x4*)p1 = d1; *(u32x4*)(p1 + (size_t)8 * ldc) = d2;
                }
            return;
        }
#pragma unroll
        for (int ai = 0; ai < 2; ++ai)
#pragma unroll
            for (int m = 0; m < 4; ++m) { bf16* rowp = O + (size_t)(rowb + ai * 128 + m * 16) * ldc + colb;
#pragma unroll
                for (int bj = 0; bj < 2; ++bj) *(u32x4*)(rowp + bj * 128) = pack8(acc[ai][bj][m][0] * scale, acc[ai][bj][m][1] * scale); }
    }
};
using EpiPlain = EpiPlainT<false>; using EpiPlainFL = EpiPlainT<true>;
struct EpiSwiglu {
    static constexpr bool CHAIN = false; static constexpr int NSTORE = 8;
    bf16* H;
    __device__ __forceinline__ void operator()(const f32x4 (&acc)[2][2][4][2], const Unit& u, int wr, int wc) const {
        unsigned em_ = ~0u; asm volatile("" : "+s"(em_)); const int el_ = (int)__builtin_amdgcn_mbcnt_hi(em_, __builtin_amdgcn_mbcnt_lo(em_, 0u)); const int fr = el_ & 15, fq = el_ >> 4;
        const int rowb = u.row0 + wr * 64 + fr, colb = (u.col0 >> 1) + wc * 32 + 8 * fq;
#pragma unroll
        for (int ai = 0; ai < 2; ++ai)
#pragma unroll
            for (int m = 0; m < 4; ++m) { bf16* rowp = (bf16*)((char*)H + ablk(rowb + ai * 128 + m * 16, colb, DFF));
                f32x4 v0 = acc[ai][0][m][0], v1 = acc[ai][0][m][1]; const f32x4 u0 = acc[ai][1][m][0], u1 = acc[ai][1][m][1];
#pragma unroll
                for (int e = 0; e < 4; ++e) { v0[e] = silu_f(v0[e]) * u0[e]; v1[e] = silu_f(v1[e]) * u1[e]; }
                *(u32x4*)rowp = pack8(v0, v1); }
    }
};
struct EpiMerge {
    static constexpr bool CHAIN = true; static constexpr int NSTORE = 0;
    const bf16* __restrict__ P; bf16* __restrict__ M;
    __device__ __forceinline__ bool chain(f32x4 (&acc)[2][2][4][2], const Unit& u, int wr, int wc) const {
        unsigned em_ = ~0u; asm volatile("" : "+s"(em_)); const int el_ = (int)__builtin_amdgcn_mbcnt_hi(em_, __builtin_amdgcn_mbcnt_lo(em_, 0u)); const int fr = el_ & 15, fq = el_ >> 4;
        const int rowb = u.row0 + wr * 64 + fr, colb = u.col0 + wc * 32 + 8 * fq, n = u.z;
        const bf16* gbase = P + (size_t)(u.row0 + 32 * (u.col0 >> 8) + 8 * n + wr * 4 + wc) * INW + GATE_OFF + (fr + 16 * fq) * 8;
        if (n < 3) {
#pragma unroll
            for (int ai = 0; ai < 2; ++ai)
#pragma unroll
                for (int mp = 0; mp < 2; ++mp) {
                    u32x4 gw[2][2];
#pragma unroll
                    for (int mm = 0; mm < 2; ++mm)
#pragma unroll
                        for (int bj = 0; bj < 2; ++bj) gw[mm][bj] = *(const u32x4*)(gbase + ((ai * 4 + 2 * mp + mm) * 2 + bj) * 512);
#pragma unroll
                    for (int mm = 0; mm < 2; ++mm)
#pragma unroll
                        for (int bj = 0; bj < 2; ++bj) { const u32x4 g = gw[mm][bj]; const int m = 2 * mp + mm;
                            acc[ai][bj][m][0] *= (f32x4){bflo(g.x), bfhi(g.x), bflo(g.y), bfhi(g.y)}; acc[ai][bj][m][1] *= (f32x4){bflo(g.z), bfhi(g.z), bflo(g.w), bfhi(g.w)}; }
                }
            return true;
        }
#pragma unroll
        for (int ai = 0; ai < 2; ++ai) {
            u32x4 gw[4][2];
#pragma unroll
            for (int m = 0; m < 4; ++m)
#pragma unroll
                for (int bj = 0; bj < 2; ++bj) gw[m][bj] = *(const u32x4*)(gbase + ((ai * 4 + m) * 2 + bj) * 512);
#pragma unroll
            for (int m = 0; m < 4; ++m)
#pragma unroll
                for (int bj = 0; bj < 2; ++bj) { const u32x4 g = gw[m][bj];
                    const f32x4 s0 = (f32x4){bflo(g.x), bfhi(g.x), bflo(g.y), bfhi(g.y)}, s1 = (f32x4){bflo(g.z), bfhi(g.z), bflo(g.w), bfhi(g.w)};
                    *(u32x4*)((char*)M + ablk(rowb + ai * 128 + m * 16, colb + bj * 128, DM)) = pack8(acc[ai][bj][m][0] * s0, acc[ai][bj][m][1] * s1); }
        }
        return false;
    }
};

template <int NN> struct TileSched {
    int nlat, ntot, cpn0, G, c, nt, ksplit, colbase, kstepB, kstepA; const char* A; const char* B; size_t at, bt;
    __device__ __forceinline__ void init(int cpn0_, int cnN, int G_, int c_, const void* A_, size_t at_, const void* B_, size_t bt_, int nt_, int ksplit_ = 1, int colbase_ = 0, int kstepB_ = 128, int kstepA_ = 128) {
        kstepA = kstepA_; kstepB = kstepB_; colbase = colbase_; nlat = 128 * NN; ntot = nlat + 8 * cnN * ksplit_; cpn0 = cpn0_; G = G_; c = c_; A = (const char*)A_; B = (const char*)B_; at = at_; bt = bt_; nt = nt_; ksplit = ksplit_; }
    __device__ __forceinline__ bool next(int i, Unit& u) const {
        const int L = i * G + c; if (L >= ntot) return false; int pm, pn; size_t koff = 0, koffB = 0; u.z = 0; u.nt = nt;
        if (L < nlat) pg8::map_tile<128, NN>(L, pm, pn);
        else if (ksplit == 1) { const int r = L - nlat; pm = 128 + (r & 7); pn = cpn0 + (r >> 3); }
        else { const int r = L - nlat, ks = r & 3, tl = r >> 2; pm = 128 + (tl & 7); pn = cpn0 + (tl >> 3); u.nt = nt >> 2; u.z = 1 + ks; koff = (size_t)ks * (nt >> 2) * kstepA; koffB = (size_t)ks * (nt >> 2) * kstepB; }
        u.row0 = pm * 256; u.col0 = colbase + pn * 256; u.a = A + (size_t)pm * at + koff; u.b = B + (size_t)pn * bt + koffB; return true; }
};
struct YSched {
    int nM, ntiles, G, c; const char* A; const char* B;
    __device__ __forceinline__ bool next(int i, Unit& u) const {
        const int j = i >> 2, n = i & 3, T = j * G + c; if (T >= ntiles) return false; int pm, pn;
        if (G == 256) { const int x = c & 7, lc = c >> 3; pn = lc & 7; pm = (j < 4) ? 32 * j + 4 * x + (lc >> 3) : 128 + x; }
        else { pn = T & 7; pm = T >> 3; }
        u.row0 = pm * 256; u.col0 = pn * 256; u.z = n; u.nt = MIXW / 64; u.a = A + ((size_t)n * RT * MIXW + (size_t)pm * 256 * MIXW) * 2; u.b = B + ((size_t)(n * DM + pn * 256) * MIXW) * 2; return true; }
};
struct DftSchedL {
    int G, c; const char* A; const char* B;
    __device__ __forceinline__ bool next(int i, Unit& u) const {
        const int L = i * G + c; if (L >= 256) return false;
        const int x = L & 7, li = L >> 3, pm = 4 * (x & 3) + (li & 3), bn = li >> 2, b = 4 * (x >> 2) + (bn >> 1), pn = bn & 1;
        u.row0 = b * SEQ + pm * 256; u.col0 = pn * 256; u.z = 0; u.nt = 4096 / 64; u.a = A + (size_t)pm * 256 * 4096 * 2; u.b = B + ((size_t)(b * 512 + pn * 256) * 4096) * 2; return true; }
};
struct DftSchedC {
    int G, c; const char* A; const char* B;
    __device__ __forceinline__ bool next(int i, Unit& u) const {
        const int L = i * G + c; if (L >= 16) return false; const int b = L >> 1, pn = L & 1;
        u.row0 = RL + b * CTXL; u.col0 = pn * 256; u.z = 0; u.nt = 512 / 64; u.a = A; u.b = B + ((size_t)(b * 512 + pn * 256) * 512) * 2; return true; }
};

struct Frame {
    LAS unsigned char* lds; int tid, lane, wave, G, c;
    unsigned char* ws; const float* in[16]; float* out;
};
__device__ __forceinline__ float wave_sum(float v) {
#pragma unroll
    for (int o = 1; o < 64; o <<= 1) v += __shfl_xor(v, o);
    return v;
}
__device__ __forceinline__ int chunk_row(int b, int ci) { return ci < 2 ? RL + b * CTXL + ci * 128 : b * SEQ + (ci - 2) * 128; }
__device__ __forceinline__ void decode_item(int it, bool lat_only, int& b, int& h, int& ci) {
    if (lat_only) { b = it >> 7; const int r = it & 127; h = r >> 5; ci = 2 + (r & 31); }
    else { b = it / 136; const int r = it % 136; h = r / NCH; ci = r % NCH; }
}

__device__ __forceinline__ int dst_row(int kind, int n) {
    if (kind == 0 && n < GATE_OFF) { int c = n; if (n < 2 * MIXW) { const int i = n & 127, hh = i >> 6, ii = i & 63, e = ii >> 5, j = ii & 31; c = (n & ~127) + 64 * hh + 2 * j + e; }
        return (c & ~255) + 128 * ((c >> 5) & 1) + 32 * ((c >> 6) & 3) + (c & 31); }
    if (kind == 0) {
        if (n >= GATE_OFF) { const int gc = n - GATE_OFF, gn = gc >> 11, d = gc & (DM - 1), pg = d >> 6, dl = d & 63, fq = 2 * ((dl >> 2) & 1) + ((dl >> 3) & 1);
            return GATE_OFF + 256 * pg + 128 * (gn >> 1) + 32 * (dl >> 4) + 8 * fq + 4 * (gn & 1) + (dl & 3); }
        return n; }
    if (kind == 3) return (n & ~255) + 128 * ((n >> 5) & 1) + 32 * ((n >> 6) & 3) + (n & 31);
    if (kind == 2) { if (n < DFF) return 256 * (n >> 7) + (n & 127); const int m = n - DFF; return 256 * (m >> 7) + 128 + (m & 127); }
    return n;
}
__device__ __forceinline__ size_t blk_off(int n, int kb, int kbytes) {
    const int q = n & 31, s = (n & ~31) + 16 * ((q >> 2) & 1) + 4 * (q >> 3) + (q & 3);
    return ((size_t)(s >> 4) * (kbytes >> 6) + (kb >> 6)) * 1024 + (s & 15) * 64 + (kb & 63);
}
__device__ __forceinline__ void cv_load_tile(const float* W, int N, int k0, int n0, LAS float* scr, int lane) {
    const int r8 = lane >> 3, cq = lane & 7; f32x4 v[8];
#pragma unroll
    for (int i = 0; i < 8; ++i) v[i] = *(const f32x4*)(W + (size_t)(k0 + 8 * i + r8) * N + n0 + 4 * cq);
#pragma unroll
    for (int i = 0; i < 8; ++i) { LAS float* d = scr + (8 * i + r8) * 33 + 4 * cq; d[0] = v[i][0]; d[1] = v[i][1]; d[2] = v[i][2]; d[3] = v[i][3]; }
    asm volatile("s_waitcnt lgkmcnt(0)" ::: "memory");
}
__device__ __forceinline__ void transpose_item(const float* W, int K, int N, bf16* WT, int kind, LAS float* scr, int item, int lane) {
    const int nblk = N / 32, kb = item / nblk, nb = item % nblk, k0 = 64 * kb, n0 = 32 * nb;
    cv_load_tile(W, N, k0, n0, scr, lane);
    const int c = lane & 7;
#pragma unroll
    for (int j = 0; j < 4; ++j) { const int n = (lane >> 3) + 8 * j; const LAS float* s = scr + (8 * c) * 33 + n;
        u32x4 o; o.x = pk2(s[0 * 33], s[1 * 33]); o.y = pk2(s[2 * 33], s[3 * 33]); o.z = pk2(s[4 * 33], s[5 * 33]); o.w = pk2(s[6 * 33], s[7 * 33]);
        *(u32x4*)((unsigned char*)WT + blk_off(dst_row(kind, n0 + n), 2 * (k0 + 8 * c), 2 * K)) = o; }
    asm volatile("s_waitcnt lgkmcnt(0)" ::: "memory");
}
__device__ __forceinline__ void transpose_item_fp8(const float* W, int K, int N, unsigned char* W8, LAS float* scr, int item, int lane) {
    const int nblk = N / 32, kb = item / nblk, nb = item % nblk, k0 = 64 * kb, n0 = 32 * nb;
    cv_load_tile(W, N, k0, n0, scr, lane);
    const int c = lane & 7;
#pragma unroll
    for (int j = 0; j < 4; ++j) { const int n = (lane >> 3) + 8 * j; const LAS float* s = scr + (8 * c) * 33 + n;
        unsigned lo = 0u, hi = 0u;
        lo = __builtin_amdgcn_cvt_pk_fp8_f32(s[0 * 33] * 64.f, s[1 * 33] * 64.f, lo, false); lo = __builtin_amdgcn_cvt_pk_fp8_f32(s[2 * 33] * 64.f, s[3 * 33] * 64.f, lo, true);
        hi = __builtin_amdgcn_cvt_pk_fp8_f32(s[4 * 33] * 64.f, s[5 * 33] * 64.f, hi, false); hi = __builtin_amdgcn_cvt_pk_fp8_f32(s[6 * 33] * 64.f, s[7 * 33] * 64.f, hi, true);
        u32x2 o; o.x = lo; o.y = hi;
        *(u32x2*)(W8 + blk_off(dst_row(0, n0 + n) - GATE_OFF, k0 + 8 * c, K)) = o; }
    asm volatile("s_waitcnt lgkmcnt(0)" ::: "memory");
}
constexpr int CV_WIN = (DM / 64) * (INW / 32), CV_BR1 = (MIXW / 64) * (DM / 32), CV_WO = (DM / 64) * (DM / 32), CV_W1 = (DM / 64) * (2 * DFF / 32), CV_W2 = (DFF / 64) * (DM / 32);
constexpr int CV_TOTAL = CV_WIN + 4 * CV_BR1 + CV_WO + CV_W1 + CV_W2;
constexpr int CV_SCR_OFF = 73728;
__device__ __forceinline__ void convert_weights(Frame& F, int l, int lo, int hi, int w0, int nw) {
    LAS float* scr = (LAS float*)(F.lds + CV_SCR_OFF + F.wave * 8448);
    const int gw = (F.c - w0) * NWAVES + F.wave, NGW = nw * NWAVES;
    for (int it = lo + gw; it < hi; it += NGW) {
        int r = it;
        if (r < CV_WIN) { if ((r % (INW / 32)) * 32 >= GATE_OFF) transpose_item_fp8(F.in[7] + (size_t)l * DM * INW, DM, INW, F.ws + WS_WIN + (size_t)GATE_OFF * DM * 2, scr, r, F.lane);
            else transpose_item(F.in[7] + (size_t)l * DM * INW, DM, INW, (bf16*)(F.ws + WS_WIN), 0, scr, r, F.lane); continue; } r -= CV_WIN;
        if (r < 4 * CV_BR1) { const int n = r / CV_BR1; transpose_item(F.in[12] + (size_t)(l * 4 + n) * MIXW * DM, MIXW, DM, (bf16*)(F.ws + WS_WBR) + (size_t)n * DM * MIXW, 1, scr, r % CV_BR1, F.lane); continue; } r -= 4 * CV_BR1;
        if (r < CV_WO) { transpose_item(F.in[13] + (size_t)l * DM * DM, DM, DM, (bf16*)(F.ws + WS_WOUT), 3, scr, r, F.lane); continue; } r -= CV_WO;
        if (r < CV_W1) { transpose_item(F.in[14] + (size_t)l * DM * 2 * DFF, DM, 2 * DFF, (bf16*)(F.ws + WS_W1), 2, scr, r, F.lane); continue; } r -= CV_W1;
        transpose_item(F.in[15] + (size_t)l * DFF * DM, DFF, DM, (bf16*)(F.ws + WS_W2), 3, scr, r, F.lane);
    }
}

__device__ __forceinline__ void p0_body(Frame& F) {
    LAS float* sc = (LAS float*)F.lds;
    for (int idx = F.tid; idx < NCOND * DM; idx += NTHR) { const int j = idx >> 11, k = idx & (DM - 1); const float v = (j < NB) ? F.in[1][j * DM + k] : F.in[3][k]; sc[idx] = v / (1.f + expf(-v)); }
    __syncthreads();
    const int gw = F.c * NWAVES + F.wave, NGW = F.G * NWAVES;
    float* modp = (float*)(F.ws + WS_MODP);
    for (int it = gw; it < DEPTH * 48 * 8; it += NGW) {
        const int l = it / 384, r = it % 384, cb = r >> 3, ks = r & 7, n = cb * 256 + 4 * F.lane;
        f32x4 acc[NCOND];
#pragma unroll
        for (int j = 0; j < NCOND; ++j) acc[j] = (f32x4){0.f, 0.f, 0.f, 0.f};
        const float* wp = F.in[4] + ((size_t)l * DM + ks * 256) * ADAW + n;
        for (int k = 0; k < 256; k += 4) {
            f32x4 w[4];
#pragma unroll
            for (int kk = 0; kk < 4; ++kk) w[kk] = *(const f32x4*)(wp + (size_t)(k + kk) * ADAW);
#pragma unroll
            for (int kk = 0; kk < 4; ++kk)
#pragma unroll
                for (int j = 0; j < NCOND; ++j) acc[j] += w[kk] * sc[j * DM + ks * 256 + k + kk];
        }
#pragma unroll
        for (int j = 0; j < NCOND; ++j) *(f32x4*)(modp + ((size_t)((l * 8 + ks) * NCOND + j)) * ADAW + n) = acc[j];
    }
    convert_weights(F, 0, 0, F.G == 256 ? CV_WIN : CV_TOTAL, 0, F.G);
    __syncthreads();
    const int gt = F.c * NTHR + F.tid, NGT = F.G * NTHR;
    float* rope = (float*)(F.ws + WS_TAB);
    for (int idx = gt; idx < 64 * 32; idx += NGT) { const int pos = idx >> 5, j = idx & 31; const float fr = powf(10000.f, -(float)(2 * j) / 64.f); const float a = (float)pos * fr; rope[2 * idx] = cosf(a); rope[2 * idx + 1] = sinf(a); }
    LAS float* ct = (LAS float*)F.lds;
    for (int i = F.tid; i < 4096; i += NTHR) ct[i] = cospif((float)i * (1.f / 2048.f));
    __syncthreads();
    bf16* dl = (bf16*)(F.ws + WS_DFTL);
    for (int idx = gt; idx < 4096 * 512; idx += NGT) { const int k = idx >> 9, j8 = (idx & 511) * 8; const int tb = j8 & 2047; const bool sn = j8 >= 2048;
        float v[8];
#pragma unroll
        for (int e = 0; e < 8; ++e) { const int t = tb + e; v[e] = !sn ? ct[(k * t) & 4095] : (t == 0 ? ct[(k * 2048) & 4095] : ct[(k * t + 1024) & 4095]); }
        u32x4 o; o.x = pk2(v[0], v[1]); o.y = pk2(v[2], v[3]); o.z = pk2(v[4], v[5]); o.w = pk2(v[6], v[7]);
        *(u32x4*)(dl + (size_t)k * 4096 + j8) = o; }
    bf16* dm = (bf16*)(F.ws + WS_TAB + 65536);
    for (int idx = gt; idx < 256 * 128; idx += NGT) { const int cp = idx >> 7, c = idx & 127; const int m = (c * (cp & 127)) & 127; dm[idx] = (bf16)f2bf(ct[(m * 32 + (cp >= 128 ? 3072 : 0)) & 4095]); }
    bf16* dc = (bf16*)(F.ws + WS_DFTC);
    for (int idx = gt; idx < 256 * 64; idx += NGT) { const int k = idx >> 6, t8 = (idx & 63) * 8; const int tb = t8 & 255, ph = (t8 >= 256) ? 1024 : 0;
        float v[8];
#pragma unroll
        for (int e = 0; e < 8; ++e) v[e] = ct[((((k * (tb + e)) & 255) << 4) + ph) & 4095];
        u32x4 o; o.x = pk2(v[0], v[1]); o.y = pk2(v[2], v[3]); o.z = pk2(v[4], v[5]); o.w = pk2(v[6], v[7]);
        *(u32x4*)(dc + (size_t)k * 512 + t8) = o; }
}
__device__ __forceinline__ void p0b_body(Frame& F) {
    const int gt = F.c * NTHR + F.tid, NGT = F.G * NTHR;
    const float* modp = (const float*)(F.ws + WS_MODP); float* mod = (float*)(F.ws + WS_MOD);
    for (int idx = gt; idx < DEPTH * NCOND * ADAW; idx += NGT) { const int n = idx % ADAW, lj = idx / ADAW, j = lj % NCOND, l = lj / NCOND;
        float s = F.in[5][l * ADAW + n];
#pragma unroll
        for (int ks = 0; ks < 8; ++ks) s += modp[((size_t)((l * 8 + ks) * NCOND + j)) * ADAW + n];
        mod[idx] = s; }
}

struct RowPass {
    const float* xl_in; const float* xc_in; float* xl_out; float* xc_out;
    const bf16* Y;
    const float* gy; int gate_off;
    const float* gx; int shift_off, scale_off; int lnext;
    int l; bool do_ctx; bf16* HX;
    unsigned char* HX8;
    const float* part;
    const bf16* Y0; const float* gy0; int gate0_off;
};
__device__ __forceinline__ void row_block(Frame& F, const RowPass& P, int row0, int nrows, int cond, const float* xin, float* xout, int xrow0) {
    LAS float* V = (LAS float*)F.lds;
    const float* mod = (const float*)(F.ws + WS_MOD);
    const bool pre = P.Y0 != nullptr && row0 < RL;
    __syncthreads();
    for (int i = F.tid; i < DM; i += NTHR) {
        V[i] = P.Y ? mod[((size_t)(P.l * NCOND + cond)) * ADAW + P.gate_off + i] * P.gy[i] : 0.f;
        if (pre) V[3 * DM + i] = mod[((size_t)(P.l * NCOND + cond)) * ADAW + P.gate0_off + i] * P.gy0[i];
        if (P.lnext >= 0) { const float* mn = mod + ((size_t)(P.lnext * NCOND + cond)) * ADAW; V[DM + i] = P.gx[i] * (1.f + mn[P.scale_off + i]); V[2 * DM + i] = mn[P.shift_off + i]; }
    }
    __syncthreads();
    for (int rr = F.wave; rr < nrows; rr += NWAVES) {
        const int row = row0 + rr; const size_t xo = (size_t)(row - xrow0) * DM;
        f32x4 xv[8];
#pragma unroll
        for (int j = 0; j < 8; ++j) xv[j] = *(const f32x4*)(xin + xo + j * 256 + 4 * F.lane);
        if (pre) {
            f32x4 yv[8]; float ss = 0.f;
#pragma unroll
            for (int j = 0; j < 8; ++j) { const u32x2 yw = *(const u32x2*)(P.Y0 + (size_t)row * DM + j * 256 + 4 * F.lane); yv[j] = (f32x4){bflo(yw.x), bfhi(yw.x), bflo(yw.y), bfhi(yw.y)}; }
#pragma unroll
            for (int j = 0; j < 8; ++j) ss += (yv[j][0] * yv[j][0] + yv[j][1] * yv[j][1]) + (yv[j][2] * yv[j][2] + yv[j][3] * yv[j][3]);
            const float rstd = __builtin_amdgcn_rsqf(wave_sum(ss) * (1.f / DM) + EPS);
#pragma unroll
            for (int j = 0; j < 8; ++j) { const f32x4 va = *(const LAS f32x4*)(V + 3 * DM + j * 256 + 4 * F.lane); xv[j] += va * (yv[j] * rstd); }
        }
        if (P.Y) {
            f32x4 yv[8]; float ss = 0.f;
            if (P.part && row >= RL) {
#pragma unroll
                for (int j = 0; j < 8; ++j) { const float* pp = P.part + (size_t)(row - RL) * DM + j * 256 + 4 * F.lane;
                    yv[j] = (*(const f32x4*)pp + *(const f32x4*)(pp + (size_t)RC * DM)) + (*(const f32x4*)(pp + (size_t)2 * RC * DM) + *(const f32x4*)(pp + (size_t)3 * RC * DM)); }
            } else {
#pragma unroll
                for (int j = 0; j < 8; ++j) { const u32x2 yw = *(const u32x2*)(P.Y + (size_t)row * DM + j * 256 + 4 * F.lane); yv[j] = (f32x4){bflo(yw.x), bfhi(yw.x), bflo(yw.y), bfhi(yw.y)}; }
            }
#pragma unroll
            for (int j = 0; j < 8; ++j) ss += (yv[j][0] * yv[j][0] + yv[j][1] * yv[j][1]) + (yv[j][2] * yv[j][2] + yv[j][3] * yv[j][3]);
            const float rstd = __builtin_amdgcn_rsqf(wave_sum(ss) * (1.f / DM) + EPS);
#pragma unroll
            for (int j = 0; j < 8; ++j) { const f32x4 va = *(const LAS f32x4*)(V + j * 256 + 4 * F.lane);
                xv[j] += va * (yv[j] * rstd);
                if (xout) *(f32x4*)(xout + xo + j * 256 + 4 * F.lane) = xv[j]; }
        }
        if (P.lnext >= 0) {
            float ss = 0.f;
#pragma unroll
            for (int j = 0; j < 8; ++j) ss += (xv[j][0] * xv[j][0] + xv[j][1] * xv[j][1]) + (xv[j][2] * xv[j][2] + xv[j][3] * xv[j][3]);
            const float rstd = __builtin_amdgcn_rsqf(wave_sum(ss) * (1.f / DM) + EPS);
#pragma unroll
            for (int j = 0; j < 8; ++j) { const f32x4 vb = *(const LAS f32x4*)(V + DM + j * 256 + 4 * F.lane), vc = *(const LAS f32x4*)(V + 2 * DM + j * 256 + 4 * F.lane);
                const f32x4 h = xv[j] * rstd * vb + vc; u32x2 o; o.x = pk2(h[0], h[1]); o.y = pk2(h[2], h[3]);
                *(u32x2*)(P.HX + (size_t)row * DM + j * 256 + 4 * F.lane) = o;
                if (P.HX8) { unsigned w8 = 0u; w8 = __builtin_amdgcn_cvt_pk_fp8_f32(h[0], h[1], w8, false); w8 = __builtin_amdgcn_cvt_pk_fp8_f32(h[2], h[3], w8, true); *(unsigned*)(P.HX8 + (size_t)row * DM + j * 256 + 4 * F.lane) = w8; } }
        }
    }
}
__device__ __forceinline__ void row_pass(Frame& F, const RowPass& P) {
    for (int blk = F.c; blk < RL / 128; blk += F.G) row_block(F, P, blk * 128, 128, (blk * 128) / SEQ, P.xl_in, P.xl_out, 0);
    if (P.do_ctx) for (int blk = F.c; blk < RC / 8; blk += F.G) row_block(F, P, RL + blk * 8, 8, NB, P.xc_in, P.xc_out, RL);
    __syncthreads();
}

__device__ __forceinline__ void conv_body(Frame& F, int l, int nrows) {
    const bf16* P = (const bf16*)(F.ws + WS_PROJ); bf16* BR = (bf16*)(F.ws + WS_BUFB); const float* cw = F.in[9] + (size_t)l * 3 * MIXW;
    const int gt = F.c * NTHR + F.tid, NGT = F.G * NTHR;
    for (int idx = gt; idx < nrows * 64; idx += NGT) {
        const int r = idx >> 6, c8 = (idx & 63) * 8; bool hl, hr;
        if (r < RL) { const int col = r & 63; hl = col > 0; hr = col < 63; } else { const int t = (r - RL) & (CTXL - 1); hl = t > 0; hr = t < CTXL - 1; }
        const bf16* pr = P + (size_t)r * INW;
        float y[3][8];
#pragma unroll
        for (int k = 0; k < 3; ++k) { const bool ok = (k == 1) || (k == 0 ? hl : hr);
            if (ok) { const bf16* q = pr + (ptrdiff_t)(k - 1) * INW; const u32x4 cwd = *(const u32x4*)(q + SCC_OFF + c8), xw = *(const u32x4*)(q + SCX_OFF + c8);
                y[k][0] = bflo(cwd.x) * bflo(xw.x); y[k][1] = bfhi(cwd.x) * bfhi(xw.x); y[k][2] = bflo(cwd.y) * bflo(xw.y); y[k][3] = bfhi(cwd.y) * bfhi(xw.y);
                y[k][4] = bflo(cwd.z) * bflo(xw.z); y[k][5] = bfhi(cwd.z) * bfhi(xw.z); y[k][6] = bflo(cwd.w) * bflo(xw.w); y[k][7] = bfhi(cwd.w) * bfhi(xw.w); }
            else {
#pragma unroll
                for (int e = 0; e < 8; ++e) y[k][e] = 0.f; } }
        const u32x4 bw = *(const u32x4*)(pr + SCB_OFF + c8);
        const float bv[8] = {bflo(bw.x), bfhi(bw.x), bflo(bw.y), bfhi(bw.y), bflo(bw.z), bfhi(bw.z), bflo(bw.w), bfhi(bw.w)};
        float o[8];
#pragma unroll
        for (int e = 0; e < 8; ++e) o[e] = bv[e] * (cw[c8 + e] * y[0][e] + cw[MIXW + c8 + e] * y[1][e] + cw[2 * MIXW + c8 + e] * y[2][e]);
        u32x4 ow; ow.x = pk2(o[0], o[1]); ow.y = pk2(o[2], o[3]); ow.z = pk2(o[4], o[5]); ow.w = pk2(o[6], o[7]);
        *(u32x4*)(BR + (size_t)3 * RT * MIXW + (size_t)r * MIXW + c8) = ow;
    }
}
__device__ __forceinline__ void scan_body(Frame& F, int l) {
    const bf16* DS = (const bf16*)(F.ws + WS_BUFA); bf16* ST = (bf16*)(F.ws + WS_ST);
    const int gt = F.c * NTHR + F.tid, NGT = F.G * NTHR;
    for (int idx = gt; idx < NB * NGRP * 2 * (GD * GD / 4); idx += NGT) {
        const int e4 = (idx & (GD * GD / 4 - 1)) * 4, bhd = __builtin_amdgcn_readfirstlane(idx >> 12), dir = bhd & 1, h = (bhd >> 1) & 3;
        const float cd = __expf(F.in[8][(l * 2 + dir) * NGRP + h] * 128.f);
        const size_t base = (size_t)bhd * NCH * (GD * GD);
        f32x4 s = (f32x4){0.f, 0.f, 0.f, 0.f};
#pragma unroll
        for (int hb = 0; hb < 1; ++hb) {
            u32x2 dw[NCH];
#pragma unroll
            for (int k = 0; k < NCH; ++k) { const int st = k, ci = (dir == 0) ? st : (st < 2 ? 1 - st : NCH + 1 - st); dw[k] = *(const u32x2*)(DS + base + (size_t)ci * (GD * GD) + e4); }
#pragma unroll
            for (int k = 0; k < NCH; ++k) {
                const int st = k, ci = (dir == 0) ? st : (st < 2 ? 1 - st : NCH + 1 - st);
                u32x2 o; o.x = pk2(s[0], s[1]); o.y = pk2(s[2], s[3]); *(u32x2*)(ST + base + (size_t)ci * (GD * GD) + e4) = o;
                const f32x4 d = (f32x4){bflo(dw[k].x), bfhi(dw[k].x), bflo(dw[k].y), bfhi(dw[k].y)};
                s = s * cd + d;
            }
        }
    }
}

typedef short s16x4 __attribute__((ext_vector_type(4)));
typedef short bf16x8 __attribute__((ext_vector_type(8)));
__device__ __forceinline__ unsigned lds_addr(const LAS void* p) { return (unsigned)(size_t)p; }
template <int PITCH> __device__ __forceinline__ void load_tile_p(LAS bf16* dst, const bf16* src, size_t ld, int tid) {
#pragma unroll
    for (int i = 0; i < 4; ++i) { const int idx = tid + 512 * i, row = idx >> 4, ch = idx & 15;
        const u32x4 v = *(const u32x4*)(src + (size_t)row * ld + ch * 8); *(LAS u32x4*)(dst + row * PITCH + ch * 8) = v; }
}
template <int OFF0, int OFF1> __device__ __forceinline__ void tr_pair(s16x4& lo, s16x4& hi, unsigned addr) {
    asm volatile("ds_read_b64_tr_b16 %0, %2 offset:%3\n\tds_read_b64_tr_b16 %1, %2 offset:%4" : "=&v"(lo), "=&v"(hi) : "v"(addr), "i"(OFF0), "i"(OFF1) : "memory");
}
template <int R2> __device__ __forceinline__ void tr_frags8(s16x4 (&lo)[8], s16x4 (&hi)[8], unsigned addr) {
    tr_pair<0, R2>(lo[0], hi[0], addr); tr_pair<32, 32 + R2>(lo[1], hi[1], addr); tr_pair<64, 64 + R2>(lo[2], hi[2], addr); tr_pair<96, 96 + R2>(lo[3], hi[3], addr);
    tr_pair<128, 128 + R2>(lo[4], hi[4], addr); tr_pair<160, 160 + R2>(lo[5], hi[5], addr); tr_pair<192, 192 + R2>(lo[6], hi[6], addr); tr_pair<224, 224 + R2>(lo[7], hi[7], addr);
    asm volatile("s_waitcnt lgkmcnt(0)" ::: "memory"); __builtin_amdgcn_sched_barrier(0);
}
#define FRAG8(lo, hi, i) __builtin_shufflevector(lo[i], hi[i], 0, 1, 2, 3, 4, 5, 6, 7)
#define MFMA16(a, b, c) __builtin_amdgcn_mfma_f32_16x16x32_bf16(a, b, c, 0, 0, 0)

__device__ __forceinline__ void ret_item_mfma(Frame& F, int l, int it, bool lat_only) {
    int b, h, ci; decode_item(it, lat_only, b, h, ci);
    const bf16* P = (const bf16*)(F.ws + WS_PROJ); const int row0 = chunk_row(b, ci);
    LAS bf16* QS = (LAS bf16*)F.lds; LAS bf16* KS = (LAS bf16*)(F.lds + 34816); LAS bf16* VS = (LAS bf16*)(F.lds + 71680); LAS bf16* SF = (LAS bf16*)(F.lds + 108544); LAS bf16* SB = KS;
    const float lgf = F.in[8][(l * 2 + 0) * NGRP + h], lgb = F.in[8][(l * 2 + 1) * NGRP + h];
    const bf16* ST = (const bf16*)(F.ws + WS_ST) + ((size_t)(((b * NGRP + h) * 2 + 0) * NCH + ci)) * (GD * GD);
    __syncthreads();
    load_tile_p<136>(QS, P + (size_t)row0 * INW + Q_OFF + h * GD, INW, F.tid);
    load_tile_p<136>(KS, P + (size_t)row0 * INW + K_OFF + h * GD, INW, F.tid);
    load_tile_p<144>(VS, P + (size_t)row0 * INW + V_OFF + h * GD, INW, F.tid);
    load_tile_p<144>(SF, ST, GD, F.tid);
    __syncthreads();
    int lane_ = F.lane; asm volatile("" : "+v"(lane_));
    const int w = F.wave, g = lane_ >> 4, n = lane_ & 15, q4 = n >> 2, p4 = n & 3;
    bf16x8 qf[4];
#pragma unroll
    for (int ks = 0; ks < 4; ++ks) qf[ks] = *(const LAS bf16x8*)(QS + (16 * w + n) * 136 + 32 * ks + 8 * g);
    bf16x8 pf[4];
    {
        f32x4 s[8];
#pragma unroll
        for (int jt = 0; jt < 8; ++jt) { s[jt] = (f32x4){0.f, 0.f, 0.f, 0.f};
#pragma unroll
            for (int ks = 0; ks < 4; ++ks) { const bf16x8 kf = *(const LAS bf16x8*)(KS + (16 * jt + n) * 136 + 32 * ks + 8 * g); s[jt] = MFMA16(kf, qf[ks], s[jt]); }
            if (jt & 1) __builtin_amdgcn_sched_barrier(0); }
        const int ic = 16 * w + n;
#pragma unroll
        for (int jb = 0; jb < 4; ++jb) { unsigned wds[4];
#pragma unroll
            for (int hf = 0; hf < 2; ++hf) { float v[4];
#pragma unroll
                for (int r = 0; r < 4; ++r) { const int d = ic - (16 * (2 * jb + hf) + 4 * g + r); const float e = __expf(((d > 0) ? lgf : lgb) * fabsf((float)d)); v[r] = s[2 * jb + hf][r] * ((d == 0) ? 2.f : e); }
                wds[2 * hf] = pk2(v[0], v[1]); wds[2 * hf + 1] = pk2(v[2], v[3]); }
            pf[jb] = __builtin_bit_cast(bf16x8, (u32x4){wds[0], wds[1], wds[2], wds[3]}); }
    }
    __syncthreads();
    load_tile_p<144>(SB, ST + (size_t)NCH * GD * GD, GD, F.tid);
    f32x4 o[8], cf[8], cb[8];
#pragma unroll
    for (int e = 0; e < 8; ++e) { o[e] = (f32x4){0.f, 0.f, 0.f, 0.f}; cf[e] = o[e]; cb[e] = o[e]; }
    {
        const unsigned va = lds_addr(VS) + (unsigned)((4 * g + q4) * 288 + p4 * 8);
#pragma unroll
        for (int jb = 0; jb < 4; ++jb) { s16x4 lo[8], hi[8]; tr_frags8<16 * 288>(lo, hi, va + jb * 32 * 288);
#pragma unroll
            for (int e = 0; e < 8; ++e) o[e] = MFMA16(FRAG8(lo, hi, e), pf[jb], o[e]); }
        const unsigned sa = lds_addr(SF) + (unsigned)((8 * g + q4) * 288 + p4 * 8);
#pragma unroll
        for (int ks = 0; ks < 4; ++ks) { s16x4 lo[8], hi[8]; tr_frags8<4 * 288>(lo, hi, sa + ks * 32 * 288);
#pragma unroll
            for (int e = 0; e < 8; ++e) cf[e] = MFMA16(FRAG8(lo, hi, e), qf[ks], cf[e]); }
    }
    __syncthreads();
    {
        const unsigned sa = lds_addr(SB) + (unsigned)((8 * g + q4) * 288 + p4 * 8);
#pragma unroll
        for (int ks = 0; ks < 4; ++ks) { s16x4 lo[8], hi[8]; tr_frags8<4 * 288>(lo, hi, sa + ks * 32 * 288);
#pragma unroll
            for (int e = 0; e < 8; ++e) cb[e] = MFMA16(FRAG8(lo, hi, e), qf[ks], cb[e]); }
    }
    bf16* BR = (bf16*)(F.ws + WS_BUFB);
    {
        const int i = 16 * w + n; const float wf = __expf(lgf * (float)(i + 1)), wb = __expf(lgb * (float)(128 - i));
        float ss = 0.f;
#pragma unroll
        for (int e = 0; e < 8; ++e) { o[e] = o[e] + wf * cf[e] + wb * cb[e]; ss += (o[e][0] * o[e][0] + o[e][1] * o[e][1]) + (o[e][2] * o[e][2] + o[e][3] * o[e][3]); }
        ss += __shfl_xor(ss, 16); ss += __shfl_xor(ss, 32);
        const float rstd = __builtin_amdgcn_rsqf(ss * (1.f / GD) + EPS); const size_t row = (size_t)(row0 + i);
        u32x2 gw[8];
#pragma unroll
        for (int e = 0; e < 8; ++e) gw[e] = *(const u32x2*)(P + row * INW + G_OFF + h * GD + 16 * e + 4 * g);
#pragma unroll
        for (int e = 0; e < 8; ++e) { u32x2 ov; ov.x = pk2(bflo(gw[e].x) * o[e][0] * rstd, bfhi(gw[e].x) * o[e][1] * rstd); ov.y = pk2(bflo(gw[e].y) * o[e][2] * rstd, bfhi(gw[e].y) * o[e][3] * rstd);
            *(u32x2*)(BR + row * MIXW + h * GD + 16 * e + 4 * g) = ov; }
    }
}

constexpr int DFTM_LDS = 0, ZS_LDS = 69632;
__device__ __forceinline__ void chdft_stage_m(Frame& F) {
    const bf16* M = (const bf16*)(F.ws + WS_TAB + 65536); LAS bf16* MS = (LAS bf16*)(F.lds + DFTM_LDS);
    __syncthreads();
#pragma unroll
    for (int i = 0; i < 8; ++i) { const int idx = F.tid + 512 * i, row = idx >> 4, ch = idx & 15; *(LAS u32x4*)(MS + row * 136 + ch * 8) = *(const u32x4*)(M + row * GD + ch * 8); }
    __syncthreads();
}
constexpr int ZP_LDS = 69632, ZM_LDS = 69632 + 34816, SPC_LDS = 69632 + 2 * 34816;
__device__ __forceinline__ void chdft_ctx_item(Frame& F, int r) {
    const int b = r >> 3, g_ = (r >> 1) & 3, ci = r & 1;
    const bf16* P = (const bf16*)(F.ws + WS_PROJ); const int row0 = chunk_row(b, ci);
    LAS bf16* MS = (LAS bf16*)(F.lds + DFTM_LDS); LAS bf16* ZS = (LAS bf16*)(F.lds + ZS_LDS);
    int tid_ = F.tid; asm volatile("" : "+v"(tid_));
    __syncthreads();
    load_tile_p<136>(ZS, P + (size_t)row0 * INW + F_OFF + g_ * GD, INW, tid_);
    __syncthreads();
    const int lane = tid_ & 63, w = F.wave, g = lane >> 4, n = lane & 15;
    bf16x8 zf[4];
#pragma unroll
    for (int ks = 0; ks < 4; ++ks) zf[ks] = *(const LAS bf16x8*)(ZS + (16 * w + n) * 136 + 32 * ks + 8 * g);
    const int t0 = ci * 128, T = CTXL;
    bf16* Z = (bf16*)(F.ws + WS_ZCT) + (size_t)NB * 512 * 8192;
#pragma unroll
    for (int half = 0; half < 2; ++half) {
        f32x4 acc[8];
#pragma unroll
        for (int ct = 0; ct < 8; ++ct) { acc[ct] = (f32x4){0.f, 0.f, 0.f, 0.f};
#pragma unroll
            for (int ks = 0; ks < 4; ++ks) { const bf16x8 mf = *(const LAS bf16x8*)(MS + (128 * half + 16 * ct + n) * 136 + 32 * ks + 8 * g); acc[ct] = MFMA16(zf[ks], mf, acc[ct]); } }
#pragma unroll
        for (int ct = 0; ct < 8; ++ct) { const int cp = g_ * GD + 16 * ct + n; bf16* dst = Z + ((size_t)(b * 512 + cp) * 2 + half) * T + t0 + 16 * w + 4 * g;
            u32x2 o; o.x = pk2(acc[ct][0], acc[ct][1]); o.y = pk2(acc[ct][2], acc[ct][3]); *(u32x2*)dst = o; }
    }
}

struct DsRegs { u32x4 k[4], v[4]; };
__device__ __forceinline__ void ds_load(Frame& F, int it, DsRegs& R) {
    int b, h, ci; decode_item(it, false, b, h, ci);
    int tid_ = F.tid; asm volatile("" : "+v"(tid_));
    const bf16* P = (const bf16*)(F.ws + WS_PROJ) + (size_t)chunk_row(b, ci) * INW + h * GD;
#pragma unroll
    for (int i = 0; i < 4; ++i) { const int idx = tid_ + 512 * i, row = idx >> 4, ch = idx & 15; R.k[i] = *(const u32x4*)(P + (size_t)row * INW + K_OFF + ch * 8); R.v[i] = *(const u32x4*)(P + (size_t)row * INW + V_OFF + ch * 8); }
}
__device__ __forceinline__ void ds_stage(Frame& F, int l, int it, const DsRegs& R) {
    int b, h, ci; decode_item(it, false, b, h, ci);
    int tid_ = F.tid; asm volatile("" : "+v"(tid_));
    LAS bf16* KS = (LAS bf16*)F.lds; LAS bf16* VF = (LAS bf16*)(F.lds + 36864); LAS bf16* VB = (LAS bf16*)(F.lds + 73728);
    const float lgf = F.in[8][(l * 2 + 0) * NGRP + h], lgb = F.in[8][(l * 2 + 1) * NGRP + h];
#pragma unroll
    for (int i = 0; i < 4; ++i) { const int idx = tid_ + 512 * i, row = idx >> 4, ch = idx & 15; const u32x4 v = R.v[i];
        *(LAS u32x4*)(KS + row * 144 + ch * 8) = R.k[i];
        const float wf = __expf(lgf * (float)(127 - row)), wb = __expf(lgb * (float)row);
        const float x[8] = {bflo(v.x), bfhi(v.x), bflo(v.y), bfhi(v.y), bflo(v.z), bfhi(v.z), bflo(v.w), bfhi(v.w)};
        u32x4 a, c; a.x = pk2(x[0] * wf, x[1] * wf); a.y = pk2(x[2] * wf, x[3] * wf); a.z = pk2(x[4] * wf, x[5] * wf); a.w = pk2(x[6] * wf, x[7] * wf);
        c.x = pk2(x[0] * wb, x[1] * wb); c.y = pk2(x[2] * wb, x[3] * wb); c.z = pk2(x[4] * wb, x[5] * wb); c.w = pk2(x[6] * wb, x[7] * wb);
        *(LAS u32x4*)(VF + row * 144 + ch * 8) = a; *(LAS u32x4*)(VB + row * 144 + ch * 8) = c; }
}
__device__ __forceinline__ void ds_compute(Frame& F, int it) {
    int b, h, ci; decode_item(it, false, b, h, ci);
    int lane_ = F.lane; asm volatile("" : "+v"(lane_));
    LAS bf16* KS = (LAS bf16*)F.lds; LAS bf16* VF = (LAS bf16*)(F.lds + 36864); LAS bf16* VB = (LAS bf16*)(F.lds + 73728);
    const int lane = lane_, w = F.wave, g = lane >> 4, n = lane & 15, q4 = n >> 2, p4 = n & 3;
    f32x4 af[8], ab[8];
#pragma unroll
    for (int e = 0; e < 8; ++e) { af[e] = (f32x4){0.f, 0.f, 0.f, 0.f}; ab[e] = af[e]; }
    const unsigned ka = lds_addr(KS) + (unsigned)((8 * g + q4) * 288 + (16 * w + 4 * p4) * 2);
    const unsigned fa = lds_addr(VF) + (unsigned)((8 * g + q4) * 288 + p4 * 8), ba = lds_addr(VB) + (unsigned)((8 * g + q4) * 288 + p4 * 8);
#pragma unroll
    for (int ks = 0; ks < 4; ++ks) {
        s16x4 klo, khi; tr_pair<0, 4 * 288>(klo, khi, ka + ks * 32 * 288);
        { s16x4 lo[8], hi[8]; tr_frags8<4 * 288>(lo, hi, fa + ks * 32 * 288); const bf16x8 kf = __builtin_shufflevector(klo, khi, 0, 1, 2, 3, 4, 5, 6, 7);
#pragma unroll
          for (int e = 0; e < 8; ++e) af[e] = MFMA16(FRAG8(lo, hi, e), kf, af[e]); }
        { s16x4 lo[8], hi[8]; tr_frags8<4 * 288>(lo, hi, ba + ks * 32 * 288); const bf16x8 kf = __builtin_shufflevector(klo, khi, 0, 1, 2, 3, 4, 5, 6, 7);
#pragma unroll
          for (int e = 0; e < 8; ++e) ab[e] = MFMA16(FRAG8(lo, hi, e), kf, ab[e]); }
    }
    bf16* DS = (bf16*)(F.ws + WS_BUFA);
    bf16* df = DS + ((size_t)(((b * NGRP + h) * 2 + 0) * NCH + ci)) * (GD * GD); bf16* db = df + (size_t)NCH * GD * GD;
#pragma unroll
    for (int e = 0; e < 8; ++e) { const int o = (16 * w + n) * GD + 16 * e + 4 * g;
        u32x2 x, y; x.x = pk2(af[e][0], af[e][1]); x.y = pk2(af[e][2], af[e][3]); y.x = pk2(ab[e][0], ab[e][1]); y.y = pk2(ab[e][2], ab[e][3]);
        *(u32x2*)(df + o) = x; *(u32x2*)(db + o) = y; }
}
__device__ __forceinline__ void ds_pipeline(Frame& F, int l) {
    DsRegs R; int it = F.c; if (it < 1088) ds_load(F, it, R);
    while (it < 1088) {
        __syncthreads(); ds_stage(F, l, it, R); __syncthreads();
        const int nit = it + F.G; if (nit < 1088) ds_load(F, nit, R);
        ds_compute(F, it); it = nit;
    }
}
struct SguRegs { u32x4 v[4]; u32x2 u[8]; };
__device__ __forceinline__ void sgu_decode(int it, bool lat_only, int& b, int& g_, int& ci) { g_ = it & 3; const int r = it >> 2; if (lat_only) { b = r >> 5; ci = 2 + (r & 31); } else { b = r / NCH; ci = r % NCH; } }
__device__ __forceinline__ void sgu_load(Frame& F, int it, bool lat_only, SguRegs& R) {
    int b, g_, ci; sgu_decode(it, lat_only, b, g_, ci);
    int tid_ = F.tid; asm volatile("" : "+v"(tid_));
    const bf16* P = (const bf16*)(F.ws + WS_PROJ) + (size_t)chunk_row(b, ci) * INW + g_ * GD;
    { const int p = tid_ >> 2, qd = tid_ & 3; const bf16* src = P + (size_t)p * INW + VS_OFF + qd * 32;
#pragma unroll
      for (int i = 0; i < 4; ++i) R.v[i] = *(const u32x4*)(src + 8 * i); }
    { const int lane = tid_ & 63, g = lane >> 4, n = lane & 15; const bf16* src = P + (size_t)(16 * F.wave + n) * INW + U_OFF + 4 * g;
#pragma unroll
      for (int e = 0; e < 8; ++e) R.u[e] = *(const u32x2*)(src + 16 * e); }
}
__device__ __forceinline__ void sgu_stage_w(Frame& F, int l, int g_) {
    int tid_ = F.tid; asm volatile("" : "+v"(tid_));
    LAS bf16* WSM = (LAS bf16*)F.lds; const float* wsg = F.in[10] + (size_t)(l * NGRP + g_) * GD * GD;
#pragma unroll
    for (int i = 0; i < 8; ++i) { const int idx = tid_ + 512 * i, row = idx >> 5, ch = idx & 31; const f32x4 v = *(const f32x4*)(wsg + row * GD + ch * 4);
        u32x2 o; o.x = pk2(v[0], v[1]); o.y = pk2(v[2], v[3]); *(LAS u32x2*)(WSM + row * 136 + ch * 4) = o; }
}
__device__ __forceinline__ void sgu_stage(Frame& F, const SguRegs& R) {
    int tid_ = F.tid; asm volatile("" : "+v"(tid_));
    LAS bf16* VN = (LAS bf16*)(F.lds + 34816);
    const int p = tid_ >> 2, qd = tid_ & 3;
    float x[32];
#pragma unroll
    for (int i = 0; i < 4; ++i) { const u32x4 w = R.v[i]; x[8 * i] = bflo(w.x); x[8 * i + 1] = bfhi(w.x); x[8 * i + 2] = bflo(w.y); x[8 * i + 3] = bfhi(w.y); x[8 * i + 4] = bflo(w.z); x[8 * i + 5] = bfhi(w.z); x[8 * i + 6] = bflo(w.w); x[8 * i + 7] = bfhi(w.w); }
    float s = 0.f;
#pragma unroll
    for (int i = 0; i < 32; ++i) s += x[i];
    s += __shfl_xor(s, 1); s += __shfl_xor(s, 2); const float mu = s * (1.f / GD); float q = 0.f;
#pragma unroll
    for (int i = 0; i < 32; ++i) { x[i] -= mu; q += x[i] * x[i]; }
    q += __shfl_xor(q, 1); q += __shfl_xor(q, 2); const float rstd = __builtin_amdgcn_rsqf(q * (1.f / GD) + EPS);
#pragma unroll
    for (int i = 0; i < 4; ++i) { u32x4 o; o.x = pk2(x[8 * i] * rstd, x[8 * i + 1] * rstd); o.y = pk2(x[8 * i + 2] * rstd, x[8 * i + 3] * rstd); o.z = pk2(x[8 * i + 4] * rstd, x[8 * i + 5] * rstd); o.w = pk2(x[8 * i + 6] * rstd, x[8 * i + 7] * rstd);
        *(LAS u32x4*)(VN + p * 144 + qd * 32 + 8 * i) = o; }
}
__device__ __forceinline__ void sgu_compute(Frame& F, int l, int it, bool lat_only, const u32x2 (&uw)[8]) {
    int b, g_, ci; sgu_decode(it, lat_only, b, g_, ci);
    int lane_ = F.lane; asm volatile("" : "+v"(lane_));
    LAS bf16* WSM = (LAS bf16*)F.lds; LAS bf16* VN = (LAS bf16*)(F.lds + 34816);
    const int lane = lane_, w = F.wave, g = lane >> 4, n = lane & 15, q4 = n >> 2, p4 = n & 3;
    f32x4 acc[8];
#pragma unroll
    for (int e = 0; e < 8; ++e) acc[e] = (f32x4){0.f, 0.f, 0.f, 0.f};
    const unsigned va = lds_addr(VN) + (unsigned)((8 * g + q4) * 288 + p4 * 8);
#pragma unroll
    for (int ks = 0; ks < 4; ++ks) { const bf16x8 wf = *(const LAS bf16x8*)(WSM + (16 * w + n) * 136 + 32 * ks + 8 * g);
        s16x4 lo[8], hi[8]; tr_frags8<4 * 288>(lo, hi, va + ks * 32 * 288);
#pragma unroll
        for (int e = 0; e < 8; ++e) acc[e] = MFMA16(FRAG8(lo, hi, e), wf, acc[e]); }
    bf16* BR = (bf16*)(F.ws + WS_BUFB);
    const int q = 16 * w + n; const float bs = F.in[11][(l * NGRP + g_) * GD + q]; const size_t row = (size_t)(chunk_row(b, ci) + q);
#pragma unroll
    for (int e = 0; e < 8; ++e) { u32x2 ov; ov.x = pk2(bflo(uw[e].x) * (acc[e][0] + bs), bfhi(uw[e].x) * (acc[e][1] + bs)); ov.y = pk2(bflo(uw[e].y) * (acc[e][2] + bs), bfhi(uw[e].y) * (acc[e][3] + bs));
        *(u32x2*)(BR + (size_t)2 * RT * MIXW + row * MIXW + g_ * GD + 16 * e + 4 * g) = ov; }
}
__device__ __forceinline__ void sgu_pipeline(Frame& F, int l, bool lat_only) {
    const int nit_all = lat_only ? 1024 : 1088;
    SguRegs R; int it = (F.c + 64) % F.G, wg = -1; if (it < nit_all) sgu_load(F, it, lat_only, R);
    while (it < nit_all) {
        __syncthreads();
        if ((it & 3) != wg) { wg = it & 3; sgu_stage_w(F, l, wg); }
        sgu_stage(F, R);
        u32x2 uw[8];
#pragma unroll
        for (int e = 0; e < 8; ++e) uw[e] = R.u[e];
        __syncthreads();
        const int nit = it + F.G; if (nit < nit_all) sgu_load(F, nit, lat_only, R);
        sgu_compute(F, l, it, lat_only, uw); it = nit;
    }
}
struct CdRegs { u32x4 a[4], m[4]; };
__device__ __forceinline__ void cd_load(Frame& F, int it, CdRegs& R) {
    const int b = it >> 6, g_ = (it >> 4) & 3, t0 = 128 * (it & 15);
    int tid_ = F.tid; asm volatile("" : "+v"(tid_));
    const bf16* P = (const bf16*)(F.ws + WS_PROJ) + (size_t)(b * SEQ) * INW + F_OFF + g_ * GD;
#pragma unroll
    for (int i = 0; i < 4; ++i) { const int idx = tid_ + 512 * i, row = idx >> 4, ch = idx & 15; const int t = t0 + row;
        R.a[i] = *(const u32x4*)(P + (size_t)t * INW + ch * 8);
        R.m[i] = (u32x4){0u, 0u, 0u, 0u}; if (t > 0) R.m[i] = *(const u32x4*)(P + (size_t)(SEQ - t) * INW + ch * 8); }
}
__device__ __forceinline__ void cd_stage(Frame& F, int it, const CdRegs& R) {
    const int b = it >> 6, g_ = (it >> 4) & 3, np = it & 15;
    int tid_ = F.tid; asm volatile("" : "+v"(tid_));
    LAS bf16* MS = (LAS bf16*)(F.lds + DFTM_LDS); LAS bf16* ZP = (LAS bf16*)(F.lds + ZP_LDS); LAS bf16* ZM = (LAS bf16*)(F.lds + ZM_LDS); LAS float* SPC = (LAS float*)(F.lds + SPC_LDS);
#pragma unroll
    for (int i = 0; i < 4; ++i) { const int idx = tid_ + 512 * i, row = idx >> 4, ch = idx & 15; const u32x4 a = R.a[i], m = R.m[i];
        u32x4 sp, sm;
        sp.x = pk2(bflo(a.x) + bflo(m.x), bfhi(a.x) + bfhi(m.x)); sp.y = pk2(bflo(a.y) + bflo(m.y), bfhi(a.y) + bfhi(m.y)); sp.z = pk2(bflo(a.z) + bflo(m.z), bfhi(a.z) + bfhi(m.z)); sp.w = pk2(bflo(a.w) + bflo(m.w), bfhi(a.w) + bfhi(m.w));
        sm.x = pk2(bflo(a.x) - bflo(m.x), bfhi(a.x) - bfhi(m.x)); sm.y = pk2(bflo(a.y) - bflo(m.y), bfhi(a.y) - bfhi(m.y)); sm.z = pk2(bflo(a.z) - bflo(m.z), bfhi(a.z) - bfhi(m.z)); sm.w = pk2(bflo(a.w) - bflo(m.w), bfhi(a.w) - bfhi(m.w));
        *(LAS u32x4*)(ZP + row * 136 + ch * 8) = sp; *(LAS u32x4*)(ZM + row * 136 + ch * 8) = sm; }
    if (np == 0 && tid_ < 128) { const bf16* zr = (const bf16*)(F.ws + WS_PROJ) + (size_t)(b * SEQ + SEQ / 2) * INW + F_OFF + g_ * GD; float acc = 0.f;
        for (int c = 0; c < 128; ++c) acc += bf1(zr[c]) * bf1(MS[tid_ * 136 + c]);
        SPC[tid_] = acc; }
}
__device__ __forceinline__ void cd_compute(Frame& F, int it) {
    const int b = it >> 6, g_ = (it >> 4) & 3, np = it & 15, t0 = 128 * np;
    int lane_ = F.lane; asm volatile("" : "+v"(lane_));
    LAS bf16* MS = (LAS bf16*)(F.lds + DFTM_LDS); LAS bf16* ZP = (LAS bf16*)(F.lds + ZP_LDS); LAS bf16* ZM = (LAS bf16*)(F.lds + ZM_LDS); LAS float* SPC = (LAS float*)(F.lds + SPC_LDS);
    const int lane = lane_, w = F.wave, g = lane >> 4, n = lane & 15;
    bf16* Z = (bf16*)(F.ws + WS_ZCT);
#pragma unroll
    for (int half = 0; half < 2; ++half) {
        const LAS bf16* ZT = half ? ZM : ZP;
        bf16x8 zf[4];
#pragma unroll
        for (int ks = 0; ks < 4; ++ks) zf[ks] = *(const LAS bf16x8*)(ZT + (16 * w + n) * 136 + 32 * ks + 8 * g);
        f32x4 acc[8];
#pragma unroll
        for (int ct = 0; ct < 8; ++ct) { acc[ct] = (f32x4){0.f, 0.f, 0.f, 0.f};
#pragma unroll
            for (int ks = 0; ks < 4; ++ks) { const bf16x8 mf = *(const LAS bf16x8*)(MS + (128 * half + 16 * ct + n) * 136 + 32 * ks + 8 * g); acc[ct] = MFMA16(zf[ks], mf, acc[ct]); } }
#pragma unroll
        for (int ct = 0; ct < 8; ++ct) { const int cp = g_ * GD + 16 * ct + n;
            if (half == 1 && np == 0 && w == 0 && g == 0) acc[ct][0] = SPC[16 * ct + n];
            bf16* dst = Z + (size_t)(b * 512 + cp) * 4096 + half * 2048 + t0 + 16 * w + 4 * g;
            u32x2 o; o.x = pk2(acc[ct][0], acc[ct][1]); o.y = pk2(acc[ct][2], acc[ct][3]); *(u32x2*)dst = o; }
    }
}
__device__ __forceinline__ void cd_pipeline(Frame& F) {
    CdRegs R; int it = (F.c + 128) % F.G; if (it < 512) cd_load(F, it, R);
    while (it < 512) {
        __syncthreads(); cd_stage(F, it, R); __syncthreads();
        const int nit = it + F.G; if (nit < 512) cd_load(F, nit, R);
        cd_compute(F, it); it = nit;
    }
}

struct Args { const float* in[16]; float* out; unsigned char* ws; int ph_lo, ph_hi; };
__global__ void __launch_bounds__(NTHR, 2) fwd_kernel(Args args) {
    extern __shared__ __attribute__((aligned(16))) unsigned char lds_raw[];
    Frame F;
    F.lds = (LAS unsigned char*)lds_raw;
    F.tid = threadIdx.x; F.lane = F.tid & 63; { int w_ = __builtin_amdgcn_readfirstlane(F.tid >> 6); asm volatile("" : "+s"(w_)); F.wave = w_; }
    F.G = gridDim.x; F.c = blockIdx.x; F.ws = args.ws; F.out = args.out;
    volatile LAS unsigned* MISC = (volatile LAS unsigned*)(F.lds + MISC_OFF);
    for (int u = F.tid; u < (LDS_BYTES - MISC_OFF) / 4; u += NTHR) MISC[u] = 0u;
    __syncthreads();
    unsigned* ctl = (unsigned*)(F.ws + WS_CTL);
    (void)xcd_barrier_post(ctl + CW_BAR, MISC + 8);
#if MK_PER_PHASE_LAUNCH
    const int lo = args.ph_lo, hi = args.ph_hi;
    int ph = 0;
#endif
#if MK_PER_PHASE_LAUNCH
#define PH_ON (ph >= lo && ph < hi)
#define PH_END do { if (ph >= lo && ph + 1 < hi) { XcdBarrier b_; b_.x = xb_xcc_id(); b_.st = (volatile LAS unsigned*)(F.lds + MISC_OFF) + 8; b_.bar = (unsigned*)(F.ws + WS_CTL) + CW_BAR; xcd_barrier(b_, F.wave == 0 && (int)__builtin_amdgcn_mbcnt_hi(~0u, __builtin_amdgcn_mbcnt_lo(~0u, 0u)) == 0); } ++ph; } while (0)
#define PH_END_LAST PH_END
#else
#define PH_ON true
#define PH_END do { XcdBarrier b_; b_.x = xb_xcc_id(); b_.st = (volatile LAS unsigned*)(F.lds + MISC_OFF) + 8; b_.bar = (unsigned*)(F.ws + WS_CTL) + CW_BAR; xcd_barrier(b_, F.wave == 0 && (int)__builtin_amdgcn_mbcnt_hi(~0u, __builtin_amdgcn_mbcnt_lo(~0u, 0u)) == 0); } while (0)
#define PH_END_LAST do { } while (0)
#endif
#define PH_TID do { unsigned m_ = ~0u; asm volatile("" : "+s"(m_)); int l_ = (int)__builtin_amdgcn_mbcnt_hi(m_, __builtin_amdgcn_mbcnt_lo(m_, 0u)); F.lane = l_; F.tid = F.wave * 64 + l_; { int c_ = blockIdx.x, g_ = gridDim.x; asm volatile("" : "+s"(c_), "+s"(g_)); F.c = c_; F.G = g_; } const __attribute__((address_space(4))) Args* ap_ = (const __attribute__((address_space(4))) Args*)__builtin_amdgcn_kernarg_segment_ptr(); asm volatile("" : "+s"(ap_)); F.ws = ap_->ws; F.out = ap_->out; _Pragma("unroll") for (int i_ = 0; i_ < 16; ++i_) F.in[i_] = ap_->in[i_]; } while (0)
#define REPS(k) for (int rep_ = 0; rep_ < 1 + ((PROBE_REP >> (k)) & 1); ++rep_)
#define REP_SYNC(k) do { if (rep_ == 1) { XcdBarrier b_; b_.x = xb_xcc_id(); b_.st = (volatile LAS unsigned*)(F.lds + MISC_OFF) + 8; b_.bar = (unsigned*)(F.ws + WS_CTL) + CW_BAR; xcd_barrier(b_, F.wave == 0 && (int)__builtin_amdgcn_mbcnt_hi(~0u, __builtin_amdgcn_mbcnt_lo(~0u, 0u)) == 0); } } while (0)
    LAS unsigned char* ring = F.lds;
#define WIN ((bf16*)(F.ws + WS_WIN))
#define WBR ((bf16*)(F.ws + WS_WBR))
#define WOUT ((bf16*)(F.ws + WS_WOUT))
#define W1 ((bf16*)(F.ws + WS_W1))
#define W2 ((bf16*)(F.ws + WS_W2))
#define BUFA ((bf16*)(F.ws + WS_BUFA))
#define BUFB ((bf16*)(F.ws + WS_BUFB))
#define PROJ ((bf16*)(F.ws + WS_PROJ))
#define XC ((float*)(F.ws + WS_XC))
#define normg (F.in[6])

    if (PH_ON) REPS(0) { REP_SYNC(0); PH_TID; p0_body(F); }
    PH_END;
    if (PH_ON) REPS(0) { REP_SYNC(0); PH_TID; p0b_body(F); }
    PH_END;
    if (PH_ON) REPS(0) { REP_SYNC(0); PH_TID; RowPass P{}; P.xl_in = F.in[0]; P.xc_in = F.in[2]; P.xl_out = nullptr; P.xc_out = nullptr; P.Y = nullptr; P.gy = nullptr; P.gate_off = 0;
        P.gx = normg + 0 * DM; P.shift_off = 0; P.scale_off = DM; P.lnext = 0; P.l = 0; P.do_ctx = true; P.HX = BUFA; P.HX8 = F.ws + WS_HX8; row_pass(F, P); }
    PH_END;

    for (int l = 0; l < DEPTH; ++l) {
        const bool last = (l == DEPTH - 1);
        if (PH_ON) REPS(1) { REP_SYNC(1); PH_TID;
            {
                pg8::Gemm g{DM, DM, DM}; TileSched<GATE_OFF / 256> S; S.init(last ? 2 : 0, last ? 4 : GATE_OFF / 256, F.G, F.c, BUFA, (size_t)256 * DM * 2, WIN, (size_t)256 * DM * 2, DM / 64);
                EpiProj E{PROJ, (const float*)(F.ws + WS_TAB), 1.f};
                pg8::gemm_phase<EpiProj, TileSched<GATE_OFF / 256>, true, true, false, false, true>(ring, g, S, E, F.wave); }
            {
                pg8::Gemm g{DM / 2, DM / 2, DM / 2}; TileSched<(INW - GATE_OFF) / 256> S; S.init(0, last ? 0 : (INW - GATE_OFF) / 256, F.G, F.c, F.ws + WS_HX8, (size_t)256 * DM, F.ws + WS_WIN + (size_t)GATE_OFF * DM * 2, (size_t)256 * DM, DM / 128, 1, GATE_OFF);
                EpiProj E{PROJ, (const float*)(F.ws + WS_TAB), 0.015625f};
                pg8::gemm_phase<EpiProj, TileSched<(INW - GATE_OFF) / 256>, true, true, false, true, true>(ring, g, S, E, F.wave); }
            if (l == 0 && F.G == 256 && F.c >= 160) convert_weights(F, 0, CV_WIN, CV_WIN + 4 * CV_BR1 + CV_WO, 160, 96); }
        PH_END;
        if (PH_ON) REPS(2) { REP_SYNC(2); PH_TID;
            const int nmix = last ? 1024 : 1088;
            (void)nmix;
            ds_pipeline(F, l);
            sgu_pipeline(F, l, last);
            chdft_stage_m(F);
            cd_pipeline(F);
            if (!last) for (int it = (F.c + 192) % F.G; it < 64; it += F.G) chdft_ctx_item(F, it);
            conv_body(F, l, last ? RL : RT);
            __syncthreads();
        }
        PH_END;
        if (PH_ON) REPS(3) { REP_SYNC(3); PH_TID;
            scan_body(F, l);
            if (!last) { pg8::Gemm g{512, 512, 512}; DftSchedC S{F.G, F.c, (const char*)(F.ws + WS_DFTC), (const char*)(F.ws + WS_ZCT + 64 * MiB)};
                EpiPlain E{BUFB + (size_t)RT * MIXW, MIXW, 0.005524271728019903f, nullptr};
                pg8::gemm_phase<EpiPlain, DftSchedC, false, true>(ring, g, S, E, F.wave); }
            { pg8::Gemm g{4096, 4096, 4096}; DftSchedL S{F.G, F.c, (const char*)(F.ws + WS_DFTL), (const char*)(F.ws + WS_ZCT)};
                EpiPlain E{BUFB + (size_t)RT * MIXW, MIXW, 0.001381067932004976f, nullptr};
                pg8::gemm_phase<EpiPlain, DftSchedL, false, true>(ring, g, S, E, F.wave); }
        }
        PH_END;
        if (PH_ON) REPS(4) { REP_SYNC(4); PH_TID; const int nmix = last ? 1024 : 1088; for (int it = (F.c + 192) % F.G; it < nmix; it += F.G) ret_item_mfma(F, l, it, last); __syncthreads(); }
        PH_END;
        if (PH_ON) REPS(5) { REP_SYNC(5); PH_TID; pg8::Gemm g{MIXW, MIXW, MIXW}; const int nM = last ? 128 : 136; YSched S{nM, nM * 8, F.G, F.c, (const char*)BUFB, (const char*)WBR};
            EpiMerge E{PROJ, BUFA};
            pg8::gemm_phase<EpiMerge, YSched, true, true, false, false, true>(ring, g, S, E, F.wave);
            if (!last && F.G == 256 && F.c >= 64) convert_weights(F, l + 1, 0, CV_WIN, 64, 192);
            if (l == 0 && F.G == 256 && F.c >= 64) convert_weights(F, 0, CV_WIN + 4 * CV_BR1 + CV_WO, CV_WIN + 4 * CV_BR1 + CV_WO + CV_W1, 64, 192); }
        PH_END;
        if (PH_ON) REPS(6) { REP_SYNC(6); PH_TID; pg8::Gemm g{DM, DM, DM}; TileSched<8> S; S.init(0, last ? 0 : 8, F.G, F.c, BUFA, (size_t)256 * DM * 2, WOUT, (size_t)256 * DM * 2, DM / 64, 4, 0, 2048, 2048);
            EpiPlainFL E{BUFB, DM, 1.f, (float*)(F.ws + WS_ZCT)};
            pg8::gemm_phase<EpiPlainFL, TileSched<8>, true, true, false, false, true, true>(ring, g, S, E, F.wave); }
        PH_END;
        if (PH_ON) { PH_TID; RowPass P{}; P.xl_in = (l == 0) ? F.in[0] : (const float*)F.out; P.xc_in = (l == 0) ? F.in[2] : (const float*)XC; P.xl_out = nullptr; P.xc_out = XC; P.Y = BUFB;
            P.gy = normg + (size_t)(l * 4 + 1) * DM; P.gate_off = 2 * DM; P.gx = normg + (size_t)(l * 4 + 2) * DM; P.shift_off = 3 * DM; P.scale_off = 4 * DM; P.lnext = l; P.l = l; P.do_ctx = !last; P.HX = BUFA; P.part = (const float*)(F.ws + WS_ZCT);
            row_pass(F, P); }
        PH_END;
        if (PH_ON) REPS(8) { REP_SYNC(8); PH_TID; pg8::Gemm g{DM, DM, DM}; TileSched<2 * DFF / 256> S; S.init(0, last ? 0 : 2 * DFF / 256, F.G, F.c, BUFA, (size_t)256 * DM * 2, W1, (size_t)256 * DM * 2, DM / 64);
            EpiSwiglu E{PROJ};
            pg8::gemm_phase<EpiSwiglu, TileSched<2 * DFF / 256>, true, true, false, false, true>(ring, g, S, E, F.wave);
            if (l == 0 && F.G == 256 && F.c >= 96) convert_weights(F, 0, CV_WIN + 4 * CV_BR1 + CV_WO + CV_W1, CV_TOTAL, 96, 160);
            if (!last && F.G == 256 && F.c >= 96) convert_weights(F, l + 1, CV_WIN, CV_WIN + 4 * CV_BR1 + CV_WO, 96, 160); }
        PH_END;
        if (PH_ON) REPS(9) { REP_SYNC(9); PH_TID; pg8::Gemm g{DFF, DFF, DFF}; TileSched<8> S; S.init(0, last ? 0 : 8, F.G, F.c, PROJ, (size_t)256 * DFF * 2, W2, (size_t)256 * DFF * 2, DFF / 64, 4, 0, 2048, 2048);
            EpiPlainFL E{BUFA, DM, 1.f, (float*)(F.ws + WS_ZCT)};
            pg8::gemm_phase<EpiPlainFL, TileSched<8>, true, true, false, false, true, true>(ring, g, S, E, F.wave); }
        PH_END;
        if (PH_ON) { PH_TID; RowPass P{}; P.xl_in = (l == 0) ? F.in[0] : (const float*)F.out; P.xc_in = XC; P.xl_out = F.out; P.xc_out = XC; P.Y = BUFA;
            P.Y0 = BUFB; P.gy0 = normg + (size_t)(l * 4 + 1) * DM; P.gate0_off = 2 * DM;
            P.gy = normg + (size_t)(l * 4 + 3) * DM; P.gate_off = 5 * DM; P.gx = last ? nullptr : normg + (size_t)((l + 1) * 4 + 0) * DM; P.shift_off = 0; P.scale_off = DM; P.lnext = last ? -1 : l + 1; P.l = l; P.do_ctx = !last; P.HX = BUFA; P.HX8 = F.ws + WS_HX8; P.part = (const float*)(F.ws + WS_ZCT);
            row_pass(F, P);
            if (!last) convert_weights(F, l + 1, F.G == 256 ? CV_WIN + 4 * CV_BR1 + CV_WO : 0, CV_TOTAL, 0, F.G); }
        if (!last) PH_END; else PH_END_LAST;
    }
#undef PH_ON
#undef PH_END
#undef PH_END_LAST
#undef WIN
#undef WBR
#undef WOUT
#undef W1
#undef W2
#undef BUFA
#undef BUFB
#undef PROJ
#undef XC
#undef normg
}

constexpr int N_PHASES = 3 + DEPTH * 10;
extern "C" void kernel_launch(void* const* d_in, const int* in_sizes, int n_in, void* d_out, int out_size, void* d_ws, size_t ws_size, hipStream_t stream) {
    static int grid = 0;
    if (grid == 0) {
        if (n_in != 16 || out_size != RL * DM || ws_size < WS_END) { fprintf(stderr, "kernel_launch: unexpected shapes (n_in %d, out %d, ws %zu < %zu); nothing launched\n", n_in, out_size, ws_size, (size_t)WS_END); grid = -1; return; }
        int dev = 0, cus = 0, per_cu = 0;
        if (hipGetDevice(&dev) != hipSuccess || hipDeviceGetAttribute(&cus, hipDeviceAttributeMultiprocessorCount, dev) != hipSuccess) { grid = -1; return; }
        if (hipFuncSetAttribute((const void*)fwd_kernel, hipFuncAttributeMaxDynamicSharedMemorySize, LDS_BYTES) != hipSuccess) { fprintf(stderr, "kernel_launch: hipFuncSetAttribute failed\n"); grid = -1; return; }
        if (hipOccupancyMaxActiveBlocksPerMultiprocessor(&per_cu, (const void*)fwd_kernel, NTHR, LDS_BYTES) != hipSuccess || per_cu < 1)
            fprintf(stderr, "kernel_launch: occupancy query reports %d workgroups per CU\n", per_cu);
        (void)hipGetLastError();
        grid = cus;
    }
    if (grid < 0) return;
    (void)in_sizes;
    if (hipMemsetAsync((char*)d_ws + WS_CTL, 0, CTL_ZERO_BYTES, stream) != hipSuccess) return;
    Args a{};
    for (int i = 0; i < 16; ++i) a.in[i] = (const float*)d_in[i];
    a.out = (float*)d_out; a.ws = (unsigned char*)d_ws;
#if MK_PER_PHASE_LAUNCH
    for (int p = 0; p < N_PHASES; ++p) { a.ph_lo = p; a.ph_hi = p + 1; hipLaunchKernelGGL(fwd_kernel, dim3(grid), dim3(NTHR), LDS_BYTES, stream, a); }
#else
    a.ph_lo = 0; a.ph_hi = N_PHASES;
    hipLaunchKernelGGL(fwd_kernel, dim3(grid), dim3(NTHR), LDS_BYTES, stream, a);
#endif
    const hipError_t le = hipPeekAtLastError();
    if (le != hipSuccess) fprintf(stderr, "kernel_launch: launch failed: %s\n", hipGetErrorName(le));
}
```

```cpp
#include <hip/hip_runtime.h>
#include <cstdio>
#include <cstdint>

#ifndef PROBE_REP
#define PROBE_REP 0
#endif
#ifndef MK_PER_PHASE_LAUNCH
#define MK_PER_PHASE_LAUNCH 0
#endif

namespace pg8 {
#define PG8_LAS __attribute__((address_space(3)))
typedef unsigned short bf16_t;
typedef short bf16x8 __attribute__((ext_vector_type(8)));
typedef float f32x4 __attribute__((ext_vector_type(4)));
typedef unsigned u32x4 __attribute__((ext_vector_type(4)));
typedef int i32x4 __attribute__((ext_vector_type(4)));
constexpr int BM = 256, BK = 64, HALF = 128, HTB = HALF * BK * 2, STAGE_BYTES = 8 * HTB, NXCD = 8, WGM = 8;

__host__ __device__ __forceinline__ int lds_byte(int r, int c) { const int st = (r >> 4) * 2 + (c >> 5), rr = r & 15, cc = c & 31, ob = rr * 64 + cc * 2; return st * 1024 + (ob ^ (((ob >> 9) & 1) << 5)); }
__host__ __device__ __forceinline__ void stage_rc(int b, int& R, int& C) { const int st = b / 1024, sb = b % 1024, swz = sb ^ (((sb >> 9) & 1) << 5); R = (st >> 1) * 16 + swz / 64; C = (st & 1) * 32 + (swz % 64) / 2; }
__host__ __device__ __forceinline__ int perm32(int rho) { const int n = rho >> 4, i = rho & 15; return 8 * (i >> 2) + 4 * n + (i & 3); }

struct Unit { int row0, col0, z, nt; const char* a; const char* b; };
struct Gemm { int lda, ldb, K; };

template <int nM, int nN> __device__ __forceinline__ void map_tile(int wgid, int& pm, int& pn) {
    constexpr int nwg = nM * nN;
    { constexpr int q = nwg / NXCD, r = nwg % NXCD; const int xcd = wgid % NXCD, off = wgid / NXCD; wgid = (xcd < r ? xcd * (q + 1) : r * (q + 1) + (xcd - r) * q) + off; }
    constexpr int nig = WGM * nN; const int gid = wgid / nig, fm = gid * WGM, gsz = (nM - fm) < WGM ? (nM - fm) : WGM;
    pm = fm + ((wgid % nig) % gsz); pn = (wgid % nig) / gsz;
}

typedef float cvt_f32x2 __attribute__((ext_vector_type(2)));
typedef __bf16 cvt_bf16x2 __attribute__((ext_vector_type(2)));
__device__ __forceinline__ unsigned cvt_pk_bf16(float lo, float hi) { const cvt_f32x2 v = {lo, hi}; const cvt_bf16x2 b = __builtin_convertvector(v, cvt_bf16x2); return __builtin_bit_cast(unsigned, b); }

template <class Epi, class Sched, bool ALIGN_EPI = false, bool SP2 = false, bool RELAX = false, bool FP8 = false, bool BLKB = false, bool BLKA = false>
__device__ __forceinline__ void gemm_phase(PG8_LAS unsigned char* lds, const Gemm g, const Sched& S, const Epi& E, const int wave_id) {
    unsigned m_ = ~0u; asm volatile("" : "+s"(m_)); int lane_ = (int)__builtin_amdgcn_mbcnt_hi(m_, __builtin_amdgcn_mbcnt_lo(m_, 0u));
    const int wid = wave_id, lane = lane_, tid = wid * 64 + lane, wr = wid >> 2, wc = wid & 3, fr = lane & 15, fq = lane >> 4;
    unsigned voffA[2], voffB[2];
#pragma unroll
    for (int i = 0; i < 2; ++i) { int R, C; stage_rc(tid * 16 + i * 8192, R, C); const int Rb = (R & ~31) + perm32(R & 31);
        voffA[i] = BLKA ? (unsigned)(((R >> 4) * ((g.lda * 2) >> 6) + ((C * 2) >> 6)) * 1024 + (R & 15) * 64 + ((C * 2) & 63)) : (unsigned)(R * g.lda + C) * 2u;
        voffB[i] = BLKB ? (unsigned)(((R >> 4) * ((g.ldb * 2) >> 6) + ((C * 2) >> 6)) * 1024 + (R & 15) * 64 + ((C * 2) & 63)) : (unsigned)(Rb * g.ldb + C) * 2u; }
    const size_t kstep = BLKA ? (size_t)2048 : (size_t)(BK * 2), kstepB = BLKB ? (size_t)2048 : (size_t)(BK * 2);
    const size_t hstepA = (size_t)HALF * g.lda * 2, hstepB = (size_t)HALF * g.ldb * 2;
    const unsigned ldsw = (unsigned)wid * 1024u;
    const int aoff = lds_byte(wr * 64 + fr, fq * 8), boff = lds_byte(wc * 32 + fr, fq * 8);
#define PG8_SA(b, h) (((b) * 2 + (h)) * HTB)
#define PG8_SB(b, h) ((4 + (b) * 2 + (h)) * HTB)
#define PG8_STAGE(bufoff, gbase, voff) do { _Pragma("unroll") for (int _i = 0; _i < 2; ++_i) \
        __builtin_amdgcn_global_load_lds((const unsigned*)((const char*)(gbase) + (voff)[_i]), (PG8_LAS unsigned*)(lds + (bufoff) + ldsw + _i * 8192), 16, 0, 0); } while (0)
#define PG8_LDA(dst, b, h) do { _Pragma("unroll") for (int m = 0; m < 4; ++m) _Pragma("unroll") for (int k = 0; k < 2; ++k) dst[m][k] = *(const PG8_LAS bf16x8*)(lds + PG8_SA(b, h) + aoff + m * 2048 + k * 1024); } while (0)
#define PG8_LDB(dst, b, h) do { _Pragma("unroll") for (int n = 0; n < 2; ++n) _Pragma("unroll") for (int k = 0; k < 2; ++k) dst[n][k] = *(const PG8_LAS bf16x8*)(lds + PG8_SB(b, h) + boff + n * 2048 + k * 1024); } while (0)
#define PG8_CAT8(x) __builtin_shufflevector(__builtin_bit_cast(i32x4, x[0]), __builtin_bit_cast(i32x4, x[1]), 0, 1, 2, 3, 4, 5, 6, 7)
#define PG8_MMA(ai, bj, At, Bt) do { __builtin_amdgcn_s_setprio(1); \
        if constexpr (FP8) { _Pragma("unroll") for (int m = 0; m < 4; ++m) _Pragma("unroll") for (int n = 0; n < 2; ++n) \
            asm volatile("v_mfma_f32_16x16x128_f8f6f4 %0, %1, %2, %0" : "+v"(acc[ai][bj][m][n]) : "v"(PG8_CAT8(Bt[n])), "v"(PG8_CAT8(At[m]))); } \
        else { _Pragma("unroll") for (int m = 0; m < 4; ++m) _Pragma("unroll") for (int n = 0; n < 2; ++n) _Pragma("unroll") for (int k = 0; k < 2; ++k) \
            acc[ai][bj][m][n] = __builtin_amdgcn_mfma_f32_16x16x32_bf16(Bt[n][k], At[m][k], acc[ai][bj][m][n], 0, 0, 0); } \
        __builtin_amdgcn_s_setprio(0); } while (0)
#define PG8_WAIT_V(n) asm volatile("s_waitcnt vmcnt(" #n ")" ::: "memory")
#define PG8_WAIT_L(n) asm volatile("s_waitcnt lgkmcnt(" #n ")" ::: "memory")
#define PG8_WAIT_VR() do { if constexpr (RELAX && Epi::NSTORE >= 16) asm volatile("s_cmp_eq_u32 %0, 0\n\ts_cbranch_scc1 1f\n\ts_waitcnt vmcnt(24)\n\ts_branch 2f\n1:\n\ts_waitcnt vmcnt(8)\n2:" :: "s"(rlx) : "scc", "memory"); \
        else if constexpr (RELAX && Epi::NSTORE >= 8) asm volatile("s_cmp_eq_u32 %0, 0\n\ts_cbranch_scc1 1f\n\ts_waitcnt vmcnt(16)\n\ts_branch 2f\n1:\n\ts_waitcnt vmcnt(8)\n2:" :: "s"(rlx) : "scc", "memory"); \
        else PG8_WAIT_V(8); } while (0)
#define PG8_BAR __builtin_amdgcn_s_barrier()
#define PG8_SCHED __builtin_amdgcn_sched_barrier(0)
    Unit cur, nxt; int ui = 0; int pre = 0;
    if (!S.next(0, cur)) return;
    f32x4 acc[2][2][4][2];
#pragma unroll
    for (int a = 0; a < 2; ++a)
#pragma unroll
        for (int b = 0; b < 2; ++b)
#pragma unroll
            for (int m = 0; m < 4; ++m)
#pragma unroll
                for (int n = 0; n < 2; ++n) acc[a][b][m][n] = (f32x4){0.f, 0.f, 0.f, 0.f};
    bf16x8 At[4][2], B0[2][2], B1[2][2];
    const char* cA = cur.a; const char* cB = cur.b;
    if constexpr (SP2) {
        PG8_STAGE(PG8_SB(0, 0), cB, voffB); PG8_STAGE(PG8_SB(0, 1), cB + hstepB, voffB); PG8_STAGE(PG8_SA(0, 0), cA, voffA); PG8_STAGE(PG8_SA(0, 1), cA + hstepA, voffA);
        if (wr == 1) PG8_BAR;
        PG8_WAIT_V(2); PG8_BAR;
        PG8_STAGE(PG8_SB(1, 0), cB + kstepB, voffB); PG8_STAGE(PG8_SA(1, 0), cA + kstep, voffA); PG8_STAGE(PG8_SB(1, 1), cB + hstepB + kstepB, voffB);
        PG8_WAIT_V(6); PG8_BAR;
    } else {
        PG8_STAGE(PG8_SB(0, 0), cB, voffB); PG8_STAGE(PG8_SA(0, 0), cA, voffA); PG8_STAGE(PG8_SB(0, 1), cB + hstepB, voffB); PG8_STAGE(PG8_SA(0, 1), cA + hstepA, voffA);
        if (wr == 1) PG8_BAR;
        PG8_WAIT_V(4); PG8_BAR;
        PG8_STAGE(PG8_SB(1, 0), cB + kstepB, voffB); PG8_STAGE(PG8_SA(1, 0), cA + kstep, voffA); PG8_STAGE(PG8_SB(1, 1), cB + hstepB + kstepB, voffB);
        PG8_WAIT_V(6); PG8_BAR;
    }
    for (;;) {
        const bool has_next = S.next(ui + 1, nxt);
        const char* nA = has_next ? nxt.a : cA; const char* nB = has_next ? nxt.b : cB;
        const int nt = cur.nt;
        for (int t = 0; t < nt; t += 2) {
            const bool last = (t == nt - 2);
            const char* a1 = cA + (size_t)(t + 1) * kstep;
            const char* a2 = last ? nA : cA + (size_t)(t + 2) * kstep; const char* b2 = last ? nB : cB + (size_t)(t + 2) * kstepB;
            const char* a3 = a2 + kstep; const char* b3 = b2 + kstepB;
            if constexpr (SP2) {
            const int rlx = (t == 0) ? pre : 0;
            PG8_LDB(B0, 0, 0); PG8_LDB(B1, 0, 1); PG8_SCHED; PG8_LDA(At, 0, 0); PG8_STAGE(PG8_SA(1, 1), a1 + hstepA, voffA);
            PG8_WAIT_VR(); PG8_WAIT_L(0); PG8_BAR; PG8_MMA(0, 0, At, B0); PG8_MMA(0, 1, At, B1); PG8_BAR; PG8_SCHED;
            PG8_LDA(At, 0, 1); PG8_STAGE(PG8_SB(0, 0), b2, voffB); PG8_STAGE(PG8_SB(0, 1), b2 + hstepB, voffB); PG8_STAGE(PG8_SA(0, 0), a2, voffA);
            PG8_WAIT_VR(); PG8_WAIT_L(0); PG8_BAR; PG8_MMA(1, 0, At, B0); PG8_MMA(1, 1, At, B1); PG8_BAR; PG8_SCHED;
            PG8_LDB(B0, 1, 0); PG8_LDB(B1, 1, 1); PG8_SCHED; PG8_LDA(At, 1, 0); PG8_STAGE(PG8_SA(0, 1), a2 + hstepA, voffA);
            PG8_WAIT_V(8); PG8_WAIT_L(0); PG8_BAR; PG8_MMA(0, 0, At, B0); PG8_MMA(0, 1, At, B1); PG8_BAR; PG8_SCHED;
            PG8_LDA(At, 1, 1); PG8_STAGE(PG8_SB(1, 0), b3, voffB); PG8_STAGE(PG8_SB(1, 1), b3 + hstepB, voffB); PG8_STAGE(PG8_SA(1, 0), a3, voffA);
            PG8_WAIT_V(8); PG8_WAIT_L(0); PG8_BAR; PG8_MMA(1, 0, At, B0); PG8_MMA(1, 1, At, B1); PG8_BAR; PG8_SCHED;
            } else {
            PG8_LDB(B0, 0, 0); PG8_SCHED; PG8_LDA(At, 0, 0); PG8_STAGE(PG8_SA(1, 1), a1 + hstepA, voffA);
            PG8_WAIT_L(8); PG8_BAR; PG8_WAIT_L(0); PG8_MMA(0, 0, At, B0); PG8_BAR; PG8_SCHED;
            PG8_LDB(B1, 0, 1); PG8_STAGE(PG8_SB(0, 0), b2, voffB);
            PG8_BAR; PG8_WAIT_L(0); PG8_MMA(0, 1, At, B1); PG8_BAR;
            PG8_LDA(At, 0, 1); PG8_STAGE(PG8_SA(0, 0), a2, voffA);
            PG8_BAR; PG8_WAIT_L(0); PG8_MMA(1, 0, At, B0); PG8_BAR; PG8_SCHED;
            PG8_STAGE(PG8_SB(0, 1), b2 + hstepB, voffB);
            PG8_WAIT_V(6); PG8_BAR; PG8_MMA(1, 1, At, B1); PG8_BAR;
            PG8_LDB(B0, 1, 0); PG8_SCHED; PG8_LDA(At, 1, 0); PG8_STAGE(PG8_SA(0, 1), a2 + hstepA, voffA);
            PG8_WAIT_L(8); PG8_BAR; PG8_WAIT_L(0); PG8_MMA(0, 0, At, B0); PG8_BAR; PG8_SCHED;
            PG8_LDB(B1, 1, 1); PG8_STAGE(PG8_SB(1, 0), b3, voffB);
            PG8_BAR; PG8_WAIT_L(0); PG8_MMA(0, 1, At, B1); PG8_BAR;
            PG8_LDA(At, 1, 1); PG8_STAGE(PG8_SA(1, 0), a3, voffA);
            PG8_BAR; PG8_WAIT_L(0); PG8_MMA(1, 0, At, B0); PG8_BAR; PG8_SCHED;
            PG8_STAGE(PG8_SB(1, 1), b3 + hstepB, voffB);
            PG8_WAIT_V(6); PG8_BAR; PG8_MMA(1, 1, At, B1); PG8_BAR;
            }
        }
        if constexpr (ALIGN_EPI) { if (wr == 0) PG8_BAR; }
        if constexpr (RELAX && SP2 && Epi::NSTORE >= 8) pre = 1;
        if constexpr (Epi::CHAIN) {
            const bool keep = E.chain(acc, cur, wr, wc);
            if (!has_next) break;
            if (!keep) {
#pragma unroll
                for (int a = 0; a < 2; ++a)
#pragma unroll
                    for (int b = 0; b < 2; ++b)
#pragma unroll
                        for (int m = 0; m < 4; ++m)
#pragma unroll
                            for (int n = 0; n < 2; ++n) acc[a][b][m][n] = (f32x4){0.f, 0.f, 0.f, 0.f};
            }
        } else {
        E(acc, cur, wr, wc);
        if (!has_next) break;
#pragma unroll
        for (int a = 0; a < 2; ++a)
#pragma unroll
            for (int b = 0; b < 2; ++b)
#pragma unroll
                for (int m = 0; m < 4; ++m)
#pragma unroll
                    for (int n = 0; n < 2; ++n) acc[a][b][m][n] = (f32x4){0.f, 0.f, 0.f, 0.f};
        }
        cur = nxt; cA = nA; cB = nB; ++ui;
        if constexpr (ALIGN_EPI) { if (wr == 1) PG8_BAR; }
    }
    PG8_WAIT_V(0);
    if constexpr (!ALIGN_EPI) { if (wr == 0) PG8_BAR; }
    PG8_BAR;
#undef PG8_SA
#undef PG8_SB
#undef PG8_STAGE
#undef PG8_LDA
#undef PG8_LDB
#undef PG8_MMA
#undef PG8_CAT8
#undef PG8_WAIT_V
#undef PG8_WAIT_L
#undef PG8_WAIT_VR
#undef PG8_BAR
#undef PG8_SCHED
}
}

constexpr int DM = 2048, NB = 8, SEQ = 4096, CTXL = 256, DEPTH = 4, MIXW = 512, GD = 128, NGRP = 4;
constexpr int INW = 13312, DFF = 5632, ADAW = 6 * DM, NCOND = NB + 1;
constexpr int RL = NB * SEQ, RC = NB * CTXL, RT = RL + RC;
constexpr int Q_OFF = 0, K_OFF = 512, V_OFF = 1024, G_OFF = 1536, F_OFF = 2048, U_OFF = 2560, VS_OFF = 3072, SCB_OFF = 3584, SCC_OFF = 4096, SCX_OFF = 4608, GATE_OFF = 5120;
constexpr int NCH = 34;
constexpr float EPS = 1e-6f;
constexpr int NWAVES = 8, NTHR = 512;

constexpr size_t MiB = 1u << 20;
constexpr size_t WS_CTL = 0, CTL_ZERO_BYTES = 1 * MiB;
constexpr size_t WS_MOD = 1 * MiB;
constexpr size_t WS_MODP = 3 * MiB;
constexpr size_t WS_TAB = 17 * MiB;
constexpr size_t WS_DFTC = 18 * MiB;
constexpr size_t WS_DFTL = 19 * MiB;
constexpr size_t WS_XC = 83 * MiB;
constexpr size_t WS_WIN = 99 * MiB;
constexpr size_t WS_WBR = 151 * MiB;
constexpr size_t WS_WOUT = 159 * MiB;
constexpr size_t WS_W1 = 167 * MiB;
constexpr size_t WS_W2 = 211 * MiB;
constexpr size_t WS_BUFA = 233 * MiB;
constexpr size_t WS_BUFB = 369 * MiB;
constexpr size_t WS_ZCT = 505 * MiB;
constexpr size_t WS_ST = 573 * MiB;
constexpr size_t WS_PROJ = 641 * MiB;
constexpr size_t WS_HX8 = 1525 * MiB;
constexpr size_t WS_END = 1593 * MiB;
static_assert(WS_PROJ + (size_t)RT * INW * 2 <= WS_END, "ws map");
static_assert((size_t)NB * NGRP * 2 * NCH * GD * GD * 4 <= WS_BUFB - WS_BUFA, "DS overlay fits BUFA");
static_assert((size_t)NB * NGRP * 2 * NCH * GD * GD * 2 <= WS_PROJ - WS_ST, "states");

constexpr int CW_TMO = 0;
constexpr int CW_BAR = 4096;

constexpr int SCR_BYTES = 155648;
constexpr int MISC_OFF = SCR_BYTES;
constexpr int LDS_BYTES = SCR_BYTES + 1024;

#define GAS __attribute__((address_space(1)))
#define LAS __attribute__((address_space(3)))
typedef unsigned short bf16;
typedef float f32x4 __attribute__((ext_vector_type(4)));
typedef float f32x2 __attribute__((ext_vector_type(2)));
typedef unsigned u32x4 __attribute__((ext_vector_type(4)));
typedef unsigned u32x2 __attribute__((ext_vector_type(2)));

__device__ __forceinline__ unsigned f2bf(float f) { unsigned u = __builtin_bit_cast(unsigned, f); return (u + 0x7fffu + ((u >> 16) & 1u)) >> 16; }
__device__ __forceinline__ unsigned pk2(float lo, float hi) { return pg8::cvt_pk_bf16(lo, hi); }
__device__ __forceinline__ float bflo(unsigned w) { return __builtin_bit_cast(float, w << 16); }
__device__ __forceinline__ float bfhi(unsigned w) { return __builtin_bit_cast(float, w & 0xffff0000u); }
__device__ __forceinline__ float bf1(unsigned short h) { return __builtin_bit_cast(float, (unsigned)h << 16); }
__device__ __forceinline__ float sigmoid_f(float x) { return __builtin_amdgcn_rcpf(1.f + __expf(-x)); }
__device__ __forceinline__ float silu_f(float x) { return x * sigmoid_f(x); }
__device__ __forceinline__ float gelu_tanh_f(float x) { const float u = 0.7978845608028654f * (x + 0.044715f * x * x * x); return x * sigmoid_f(2.f * u); }

#define XB_TMO      128
#define XB_XCNT(j)  (256  + 64 * (j))
#define XB_XSUB(j)  (1280 + 64 * (j))
#define XB_XGEN(j)  (2304 + 64 * (j))
#define XB_TOP      3328
#define XB_TOPGEN   3392
#define XCD_BAR_WORDS 3456
#define XB_SPIN_CAP (1u << 18)
__device__ __forceinline__ unsigned xb_ld(unsigned* p)              { return __hip_atomic_load(p, __ATOMIC_RELAXED, __HIP_MEMORY_SCOPE_AGENT); }
__device__ __forceinline__ unsigned xb_add(unsigned* p, unsigned v) { return __hip_atomic_fetch_add(p, v, __ATOMIC_RELAXED, __HIP_MEMORY_SCOPE_AGENT); }
__device__ __forceinline__ unsigned xb_xcc_id() { return (unsigned)__builtin_amdgcn_s_getreg((3 << 11) | 20) & 0xFu; }
#define XB_SPIN(cond, bar) do { unsigned _sp = 0; while (cond) { __builtin_amdgcn_s_sleep(1); \
    if ((++_sp & 255u) == 0u) { if (xb_ld(&(bar)[XB_TMO])) break; if (_sp > XB_SPIN_CAP) { atomicAdd(&(bar)[XB_TMO], 1u); break; } } } } while (0)
struct XcdBarrier { unsigned* bar; unsigned x; volatile LAS unsigned* st; };
__device__ __forceinline__ XcdBarrier xcd_barrier_post(unsigned* bar, volatile LAS unsigned* st) {
    XcdBarrier b; b.bar = bar; b.x = xb_xcc_id(); b.st = st;
    if (threadIdx.x == 0) (void)xb_add(&bar[XB_XCNT(b.x)], 1u);
    return b;
}
__device__ __forceinline__ void xcd_barrier_complete(unsigned* bar, unsigned x, unsigned& nloc, unsigned& nx) {
    const unsigned G = gridDim.x * gridDim.y * gridDim.z;
    unsigned sum, cnt, mine, sp = 0u;
    for (;;) {
        sum = 0u; cnt = 0u; mine = 0u;
#pragma unroll
        for (unsigned j = 0; j < 16; ++j) { const unsigned c = xb_ld(&bar[XB_XCNT(j)]); sum += c; cnt += (c > 0u) ? 1u : 0u; mine = (j == x) ? c : mine; }
        if (sum == G) break;
        __builtin_amdgcn_s_sleep(1);
        if ((++sp & 255u) == 0u) { if (xb_ld(&bar[XB_TMO])) break; if (sp > XB_SPIN_CAP) { atomicAdd(&bar[XB_TMO], 1u); break; } }
    }
    nloc = mine > 0u ? mine : 1u; nx = cnt > 0u ? cnt : 1u;
}
__device__ __forceinline__ void xcd_barrier(const XcdBarrier& b, const bool leader  ) {
    asm volatile("s_waitcnt vmcnt(0)" ::: "memory");
    __syncthreads();
    if (leader) {
        unsigned* bar = b.bar;
        __builtin_amdgcn_s_waitcnt(0);
        unsigned nloc = b.st[0], nx = b.st[1];
        if (nloc == 0u) { xcd_barrier_complete(bar, b.x, nloc, nx); b.st[0] = nloc; b.st[1] = nx; }
        const unsigned old = xb_add(&bar[XB_XSUB(b.x)], 1u);
        const unsigned gen = old / nloc;
        if (old + 1u == (gen + 1u) * nloc) {
            __builtin_amdgcn_fence(__ATOMIC_RELEASE, "agent");
            asm volatile("s_waitcnt vmcnt(0)" ::: "memory");
            const unsigned og = xb_add(&bar[XB_TOP], 1u);
            const unsigned tg = og / nx;
            if (og + 1u == (tg + 1u) * nx) xb_add(&bar[XB_TOPGEN], 1u);
            else XB_SPIN(xb_ld(&bar[XB_TOPGEN]) == tg, bar);
            __builtin_amdgcn_fence(__ATOMIC_ACQUIRE, "agent");
            xb_add(&bar[XB_XGEN(b.x)], 1u);
            asm volatile("s_waitcnt vmcnt(0)" ::: "memory");
        } else {
            XB_SPIN(xb_ld(&bar[XB_XGEN(b.x)]) == gen, bar);
            __builtin_amdgcn_fence(__ATOMIC_ACQUIRE, "agent");
            asm volatile("s_waitcnt vmcnt(0)" ::: "memory");
        }
    }
    __syncthreads();
}

using pg8::Unit; using pg8::cvt_pk_bf16;
__device__ __forceinline__ u32x4 pack8(const f32x4 v0, const f32x4 v1) { u32x4 w; w.x = cvt_pk_bf16(v0[0], v0[1]); w.y = cvt_pk_bf16(v0[2], v0[3]); w.z = cvt_pk_bf16(v1[0], v1[1]); w.w = cvt_pk_bf16(v1[2], v1[3]); return w; }

struct EpiProj {
    static constexpr bool CHAIN = false; static constexpr int NSTORE = 16;
    bf16* O; const float* rope; float gsc;
    __device__ __forceinline__ void operator()(const f32x4 (&acc)[2][2][4][2], const Unit& u, int wr, int wc) const {
        unsigned em_ = ~0u; asm volatile("" : "+s"(em_)); const int el_ = (int)__builtin_amdgcn_mbcnt_hi(em_, __builtin_amdgcn_mbcnt_lo(em_, 0u)); const int fr = el_ & 15, fq = el_ >> 4;
        const int col0 = u.col0; const bool ctx = u.row0 >= RL;
        int act;
        if (col0 < K_OFF) act = ctx ? 0 : 4; else if (col0 < V_OFF) act = ctx ? 6 : 5; else if (col0 < G_OFF) act = 0; else if (col0 < F_OFF) act = 1;
        else if (col0 < U_OFF) act = 0; else if (col0 < SCB_OFF) act = 2; else if (col0 < GATE_OFF) act = 0; else act = 3;
        const float ksc = (act == 5 || act == 6) ? 0.08838834764831845f : 1.f;
        const int rowb = u.row0 + wr * 64 + fr, colb = col0 + wc * 32 + 8 * fq;
        if (act == 3) {
            const float nsc = -1.4426950408889634f * gsc;
            const int pg = (col0 - GATE_OFF) >> 8, pn_c = pg >> 2, bj_c = (pg >> 1) & 1, w_c = wr * 4 + ((pg & 1) << 1) + (wc >> 1), lane_c = fr + 16 * (2 * (wc & 1) + (fq & 1));
            const int slot0 = u.row0 + 32 * pn_c + w_c + ((fq >> 1) ? 8 : 0);
#pragma unroll
            for (int ai = 0; ai < 2; ++ai)
#pragma unroll
                for (int m = 0; m < 4; ++m) {
                    bf16* rowp = O + (size_t)slot0 * INW + GATE_OFF + (((ai * 4 + m) * 2 + bj_c) * 64 + lane_c) * 8;
                    unsigned ow[4][2];
#pragma unroll
                    for (int hp = 0; hp < 2; ++hp) {
                        float t[4][2], r[4][2];
#pragma unroll
                        for (int gn = 0; gn < 4; ++gn)
#pragma unroll
                            for (int e = 0; e < 2; ++e) { t[gn][e] = 1.f + __builtin_amdgcn_exp2f(fminf(acc[ai][gn >> 1][m][gn & 1][2 * hp + e] * nsc, 86.5617f)); r[gn][e] = __builtin_amdgcn_rcpf(t[gn][e]); }
#pragma unroll
                        for (int gn = 0; gn < 4; ++gn) ow[gn][hp] = (gn < 3) ? cvt_pk_bf16(t[gn + 1 > 3 ? 3 : gn + 1][0] * r[gn][0], t[gn + 1 > 3 ? 3 : gn + 1][1] * r[gn][1]) : cvt_pk_bf16(r[3][0], r[3][1]);
                    }
#pragma unroll
                    for (int pr = 0; pr < 4; pr += 2) {
                        const auto sx = __builtin_amdgcn_permlane32_swap(ow[pr][0], ow[pr + 1][0], false, false);
                        const auto sy = __builtin_amdgcn_permlane32_swap(ow[pr][1], ow[pr + 1][1], false, false);
                        u32x4 o; o.x = sx[0]; o.y = sy[0]; o.z = sx[1]; o.w = sy[1];
                        *(u32x4*)(rowp + (size_t)(8 * pr) * INW) = o; }
                    __builtin_amdgcn_sched_barrier(0);
                }
            return;
        }
        const bool hi = fr >= 8;
#pragma unroll
        for (int ai = 0; ai < 2; ++ai)
#pragma unroll
            for (int m = 0; m < 4; ++m) {
                const int rowg = u.row0 + wr * 64 + ai * 128 + m * 16, row = rowg + fr;
                u32x4 w[2];
#pragma unroll
                for (int bj = 0; bj < 2; ++bj) {
                    f32x4 v0 = acc[ai][bj][m][0], v1 = acc[ai][bj][m][1];
                    if (act == 1) {
#pragma unroll
                        for (int e = 0; e < 4; ++e) { v0[e] = silu_f(v0[e]); v1[e] = silu_f(v1[e]); }
                    } else if (act == 2) {
#pragma unroll
                        for (int e = 0; e < 4; ++e) { v0[e] = gelu_tanh_f(v0[e]); v1[e] = gelu_tanh_f(v1[e]); }
                    } else if (act == 4 || act == 5) {
                        const int t = row & (SEQ - 1); const int pos = (wc & 1) ? (t & 63) : (t >> 6); const int j0 = 16 * bj + 4 * fq;
                        const f32x4* rp = (const f32x4*)(rope + (size_t)(pos * 32 + j0) * 2); const f32x4 cs0 = rp[0], cs1 = rp[1];
                        f32x4 o0, o1;
                        o0[0] = v0[0] * cs0[0] - v0[1] * cs0[1]; o0[1] = v0[0] * cs0[1] + v0[1] * cs0[0];
                        o0[2] = v0[2] * cs0[2] - v0[3] * cs0[3]; o0[3] = v0[2] * cs0[3] + v0[3] * cs0[2];
                        o1[0] = v1[0] * cs1[0] - v1[1] * cs1[1]; o1[1] = v1[0] * cs1[1] + v1[1] * cs1[0];
                        o1[2] = v1[2] * cs1[2] - v1[3] * cs1[3]; o1[3] = v1[2] * cs1[3] + v1[3] * cs1[2];
                        v0 = o0 * ksc; v1 = o1 * ksc;
                    } else if (act == 6) { v0 = v0 * ksc; v1 = v1 * ksc; }
                    w[bj] = pack8(v0, v1);
                }
                u32x4 snd, rcv, d1, d2;
                snd.x = hi ? w[0].x : w[1].x; snd.y = hi ? w[0].y : w[1].y; snd.z = hi ? w[0].z : w[1].z; snd.w = hi ? w[0].w : w[1].w;
                rcv.x = (unsigned)__builtin_amdgcn_update_dpp(0, (int)snd.x, 0x128, 0xf, 0xf, false); rcv.y = (unsigned)__builtin_amdgcn_update_dpp(0, (int)snd.y, 0x128, 0xf, 0xf, false);
                rcv.z = (unsigned)__builtin_amdgcn_update_dpp(0, (int)snd.z, 0x128, 0xf, 0xf, false); rcv.w = (unsigned)__builtin_amdgcn_update_dpp(0, (int)snd.w, 0x128, 0xf, 0xf, false);
                d1.x = hi ? rcv.x : w[0].x; d1.y = hi ? rcv.y : w[0].y; d1.z = hi ? rcv.z : w[0].z; d1.w = hi ? rcv.w : w[0].w;
                d2.x = hi ? w[1].x : rcv.x; d2.y = hi ? w[1].y : rcv.y; d2.z = hi ? w[1].z : rcv.z; d2.w = hi ? w[1].w : rcv.w;
                bf16* p1 = O + (size_t)(rowg + (fr & 7)) * INW + col0 + wc * 64 + (hi ? 32 : 0) + 8 * fq;
                *(u32x4*)p1 = d1; *(u32x4*)(p1 + (size_t)8 * INW) = d2;
            }
    }
};
__device__ __forceinline__ size_t ablk(int r, int c, int K) { return ((size_t)(r >> 4) * (K >> 5) + (c >> 5)) * 1024 + (r & 15) * 64 + (c & 31) * 2; }
template <bool FL> struct EpiPlainT {
    static constexpr bool CHAIN = false; static constexpr int NSTORE = 16;
    bf16* O; int ldc; float scale; float* part;
    __device__ __forceinline__ void operator()(const f32x4 (&acc)[2][2][4][2], const Unit& u, int wr, int wc) const {
        unsigned em_ = ~0u; asm volatile("" : "+s"(em_)); const int el_ = (int)__builtin_amdgcn_mbcnt_hi(em_, __builtin_amdgcn_mbcnt_lo(em_, 0u)); const int fr = el_ & 15, fq = el_ >> 4;
        const int rowb = u.row0 + wr * 64 + fr, colb = u.col0 + (FL ? wc * 64 : wc * 32) + 8 * fq; constexpr int BJS = FL ? 32 : 128;
        if (u.z > 0) {
            float* pb = part + ((size_t)(u.z - 1) * RC + (rowb - RL)) * DM + colb;
#pragma unroll
            for (int ai = 0; ai < 2; ++ai)
#pragma unroll
                for (int m = 0; m < 4; ++m) { float* rowp = pb + (size_t)(ai * 128 + m * 16) * DM;
#pragma unroll
                    for (int bj = 0; bj < 2; ++bj) { *(f32x4*)(rowp + bj * BJS) = acc[ai][bj][m][0]; *(f32x4*)(rowp + bj * BJS + 4) = acc[ai][bj][m][1]; } }
            return;
        }
        if (FL) {
            const bool hi = fr >= 8;
#pragma unroll
            for (int ai = 0; ai < 2; ++ai)
#pragma unroll
                for (int m = 0; m < 4; ++m) {
                    const u32x4 w0 = pack8(acc[ai][0][m][0] * scale, acc[ai][0][m][1] * scale), w1 = pack8(acc[ai][1][m][0] * scale, acc[ai][1][m][1] * scale);
                    u32x4 snd, rcv, d1, d2;
                    snd.x = hi ? w0.x : w1.x; snd.y = hi ? w0.y : w1.y; snd.z = hi ? w0.z : w1.z; snd.w = hi ? w0.w : w1.w;
                    rcv.x = (unsigned)__builtin_amdgcn_update_dpp(0, (int)snd.x, 0x128, 0xf, 0xf, false); rcv.y = (unsigned)__builtin_amdgcn_update_dpp(0, (int)snd.y, 0x128, 0xf, 0xf, false);
                    rcv.z = (unsigned)__builtin_amdgcn_update_dpp(0, (int)snd.z, 0x128, 0xf, 0xf, false); rcv.w = (unsigned)__builtin_amdgcn_update_dpp(0, (int)snd.w, 0x128, 0xf, 0xf, false);
                    d1.x = hi ? rcv.x : w0.x; d1.y = hi ? rcv.y : w0.y; d1.z = hi ? rcv.z : w0.z; d1.w = hi ? rcv.w : w0.w;
                    d2.x = hi ? w1.x : rcv.x; d2.y = hi ? w1.y : rcv.y; d2.z = hi ? w1.z : rcv.z; d2.w = hi ? w1.w : rcv.w;
                    bf16* p1 = O + (size_t)(u.row0 + wr * 64 + ai * 128 + m * 16 + (fr & 7)) * ldc + colb + (hi ? 32 : 0);
                    *(u32x4*)p1 = d1; *(u32x4*)(p1 + (size_t)8 * ldc) = d2;
                }
            return;
        }
#pragma unroll
        for (int ai = 0; ai < 2; ++ai)
#pragma unroll
            for (int m = 0; m < 4; ++m) { bf16* rowp = O + (size_t)(rowb + ai * 128 + m * 16) * ldc + colb;
#pragma unroll
                for (int bj = 0; bj < 2; ++bj) *(u32x4*)(rowp + bj * 128) = pack8(acc[ai][bj][m][0] * scale, acc[ai][bj][m][1] * scale); }
    }
};
using EpiPlain = EpiPlainT<false>; using EpiPlainFL = EpiPlainT<true>;
struct EpiSwiglu {
    static constexpr bool CHAIN = false; static constexpr int NSTORE = 8;
    bf16* H;
    __device__ __forceinline__ void operator()(const f32x4 (&acc)[2][2][4][2], const Unit& u, int wr, int wc) const {
        unsigned em_ = ~0u; asm volatile("" : "+s"(em_)); const int el_ = (int)__builtin_amdgcn_mbcnt_hi(em_, __builtin_amdgcn_mbcnt_lo(em_, 0u)); const int fr = el_ & 15, fq = el_ >> 4;
        const int rowb = u.row0 + wr * 64 + fr, colb = (u.col0 >> 1) + wc * 32 + 8 * fq;
#pragma unroll
        for (int ai = 0; ai < 2; ++ai)
#pragma unroll
            for (int m = 0; m < 4; ++m) { bf16* rowp = (bf16*)((char*)H + ablk(rowb + ai * 128 + m * 16, colb, DFF));
                f32x4 v0 = acc[ai][0][m][0], v1 = acc[ai][0][m][1]; const f32x4 u0 = acc[ai][1][m][0], u1 = acc[ai][1][m][1];
#pragma unroll
                for (int e = 0; e < 4; ++e) { v0[e] = silu_f(v0[e]) * u0[e]; v1[e] = silu_f(v1[e]) * u1[e]; }
                *(u32x4*)rowp = pack8(v0, v1); }
    }
};
struct EpiMerge {
    static constexpr bool CHAIN = true; static constexpr int NSTORE = 0;
    const bf16* __restrict__ P; bf16* __restrict__ M;
    __device__ __forceinline__ bool chain(f32x4 (&acc)[2][2][4][2], const Unit& u, int wr, int wc) const {
        unsigned em_ = ~0u; asm volatile("" : "+s"(em_)); const int el_ = (int)__builtin_amdgcn_mbcnt_hi(em_, __builtin_amdgcn_mbcnt_lo(em_, 0u)); const int fr = el_ & 15, fq = el_ >> 4;
        const int rowb = u.row0 + wr * 64 + fr, colb = u.col0 + wc * 32 + 8 * fq, n = u.z;
        const bf16* gbase = P + (size_t)(u.row0 + 32 * (u.col0 >> 8) + 8 * n + wr * 4 + wc) * INW + GATE_OFF + (fr + 16 * fq) * 8;
        if (n < 3) {
#pragma unroll
            for (int ai = 0; ai < 2; ++ai)
#pragma unroll
                for (int mp = 0; mp < 2; ++mp) {
                    u32x4 gw[2][2];
#pragma unroll
                    for (int mm = 0; mm < 2; ++mm)
#pragma unroll
                        for (int bj = 0; bj < 2; ++bj) gw[mm][bj] = *(const u32x4*)(gbase + ((ai * 4 + 2 * mp + mm) * 2 + bj) * 512);
#pragma unroll
                    for (int mm = 0; mm < 2; ++mm)
#pragma unroll
                        for (int bj = 0; bj < 2; ++bj) { const u32x4 g = gw[mm][bj]; const int m = 2 * mp + mm;
                            acc[ai][bj][m][0] *= (f32x4){bflo(g.x), bfhi(g.x), bflo(g.y), bfhi(g.y)}; acc[ai][bj][m][1] *= (f32x4){bflo(g.z), bfhi(g.z), bflo(g.w), bfhi(g.w)}; }
                }
            return true;
        }
#pragma unroll
        for (int ai = 0; ai < 2; ++ai) {
            u32x4 gw[4][2];
#pragma unroll
            for (int m = 0; m < 4; ++m)
#pragma unroll
                for (int bj = 0; bj < 2; ++bj) gw[m][bj] = *(const u32x4*)(gbase + ((ai * 4 + m) * 2 + bj) * 512);
#pragma unroll
            for (int m = 0; m < 4; ++m)
#pragma unroll
                for (int bj = 0; bj < 2; ++bj) { const u32x4 g = gw[m][bj];
                    const f32x4 s0 = (f32x4){bflo(g.x), bfhi(g.x), bflo(g.y), bfhi(g.y)}, s1 = (f32x4){bflo(g.z), bfhi(g.z), bflo(g.w), bfhi(g.w)};
                    *(u32x4*)((char*)M + ablk(rowb + ai * 128 + m * 16, colb + bj * 128, DM)) = pack8(acc[ai][bj][m][0] * s0, acc[ai][bj][m][1] * s1); }
        }
        return false;
    }
};

template <int NN> struct TileSched {
    int nlat, ntot, cpn0, G, c, nt, ksplit, colbase, kstepB, kstepA; const char* A; const char* B; size_t at, bt;
    __device__ __forceinline__ void init(int cpn0_, int cnN, int G_, int c_, const void* A_, size_t at_, const void* B_, size_t bt_, int nt_, int ksplit_ = 1, int colbase_ = 0, int kstepB_ = 128, int kstepA_ = 128) {
        kstepA = kstepA_; kstepB = kstepB_; colbase = colbase_; nlat = 128 * NN; ntot = nlat + 8 * cnN * ksplit_; cpn0 = cpn0_; G = G_; c = c_; A = (const char*)A_; B = (const char*)B_; at = at_; bt = bt_; nt = nt_; ksplit = ksplit_; }
    __device__ __forceinline__ bool next(int i, Unit& u) const {
        const int L = i * G + c; if (L >= ntot) return false; int pm, pn; size_t koff = 0, koffB = 0; u.z = 0; u.nt = nt;
        if (L < nlat) pg8::map_tile<128, NN>(L, pm, pn);
        else if (ksplit == 1) { const int r = L - nlat; pm = 128 + (r & 7); pn = cpn0 + (r >> 3); }
        else { const int r = L - nlat, ks = r & 3, tl = r >> 2; pm = 128 + (tl & 7); pn = cpn0 + (tl >> 3); u.nt = nt >> 2; u.z = 1 + ks; koff = (size_t)ks * (nt >> 2) * kstepA; koffB = (size_t)ks * (nt >> 2) * kstepB; }
        u.row0 = pm * 256; u.col0 = colbase + pn * 256; u.a = A + (size_t)pm * at + koff; u.b = B + (size_t)pn * bt + koffB; return true; }
};
struct YSched {
    int nM, ntiles, G, c; const char* A; const char* B;
    __device__ __forceinline__ bool next(int i, Unit& u) const {
        const int j = i >> 2, n = i & 3, T = j * G + c; if (T >= ntiles) return false; int pm, pn;
        if (G == 256) { const int x = c & 7, lc = c >> 3; pn = lc & 7; pm = (j < 4) ? 32 * j + 4 * x + (lc >> 3) : 128 + x; }
        else { pn = T & 7; pm = T >> 3; }
        u.row0 = pm * 256; u.col0 = pn * 256; u.z = n; u.nt = MIXW / 64; u.a = A + ((size_t)pm * 256 * DM + n * MIXW) * 2; u.b = B + ((size_t)(n * DM + pn * 256) * MIXW) * 2; return true; }
};
struct DftSchedL {
    int G, c; const char* A; const char* B;
    __device__ __forceinline__ bool next(int i, Unit& u) const {
        const int L = i * G + c; if (L >= 256) return false;
        const int x = L & 7, li = L >> 3, pm = 4 * (x & 3) + (li & 3), bn = li >> 2, b = 4 * (x >> 2) + (bn >> 1), pn = bn & 1;
        u.row0 = b * SEQ + pm * 256; u.col0 = MIXW + pn * 256; u.z = 0; u.nt = 4096 / 64; u.a = A + (size_t)pm * 256 * 4096 * 2; u.b = B + ((size_t)(b * 512 + pn * 256) * 4096) * 2; return true; }
};
struct DftSchedC {
    int G, c; const char* A; const char* B;
    __device__ __forceinline__ bool next(int i, Unit& u) const {
        const int L = i * G + c; if (L >= 16) return false; const int b = L >> 1, pn = L & 1;
        u.row0 = RL + b * CTXL; u.col0 = MIXW + pn * 256; u.z = 0; u.nt = 512 / 64; u.a = A; u.b = B + ((size_t)(b * 512 + pn * 256) * 512) * 2; return true; }
};

struct Frame {
    LAS unsigned char* lds; int tid, lane, wave, G, c;
    unsigned char* ws; const float* in[16]; float* out;
};
__device__ __forceinline__ float wave_sum(float v) {
#pragma unroll
    for (int o = 1; o < 64; o <<= 1) v += __shfl_xor(v, o);
    return v;
}
__device__ __forceinline__ int chunk_row(int b, int ci) { return ci < 2 ? RL + b * CTXL + ci * 128 : b * SEQ + (ci - 2) * 128; }
__device__ __forceinline__ void decode_item(int it, bool lat_only, int& b, int& h, int& ci) {
    if (lat_only) { b = it >> 7; const int r = it & 127; h = r >> 5; ci = 2 + (r & 31); }
    else { b = it / 136; const int r = it % 136; h = r / NCH; ci = r % NCH; }
}

__device__ __forceinline__ int dst_row(int kind, int n) {
    if (kind == 0 && n < GATE_OFF) { int c = n; if (n < 2 * MIXW) { const int i = n & 127, hh = i >> 6, ii = i & 63, e = ii >> 5, j = ii & 31; c = (n & ~127) + 64 * hh + 2 * j + e; }
        return (c & ~255) + 128 * ((c >> 5) & 1) + 32 * ((c >> 6) & 3) + (c & 31); }
    if (kind == 0) {
        if (n >= GATE_OFF) { const int gc = n - GATE_OFF, gn = gc >> 11, d = gc & (DM - 1), pg = d >> 6, dl = d & 63, fq = 2 * ((dl >> 2) & 1) + ((dl >> 3) & 1);
            return GATE_OFF + 256 * pg + 128 * (gn >> 1) + 32 * (dl >> 4) + 8 * fq + 4 * (gn & 1) + (dl & 3); }
        return n; }
    if (kind == 3) return (n & ~255) + 128 * ((n >> 5) & 1) + 32 * ((n >> 6) & 3) + (n & 31);
    if (kind == 2) { if (n < DFF) return 256 * (n >> 7) + (n & 127); const int m = n - DFF; return 256 * (m >> 7) + 128 + (m & 127); }
    return n;
}
__device__ __forceinline__ size_t blk_off(int n, int kb, int kbytes) {
    const int q = n & 31, s = (n & ~31) + 16 * ((q >> 2) & 1) + 4 * (q >> 3) + (q & 3);
    return ((size_t)(s >> 4) * (kbytes >> 6) + (kb >> 6)) * 1024 + (s & 15) * 64 + (kb & 63);
}
__device__ __forceinline__ void cv_load_tile(const float* W, int N, int k0, int n0, LAS float* scr, int lane) {
    const int r8 = lane >> 3, cq = lane & 7; f32x4 v[8];
#pragma unroll
    for (int i = 0; i < 8; ++i) v[i] = *(const f32x4*)(W + (size_t)(k0 + 8 * i + r8) * N + n0 + 4 * cq);
#pragma unroll
    for (int i = 0; i < 8; ++i) { LAS float* d = scr + (8 * i + r8) * 33 + 4 * cq; d[0] = v[i][0]; d[1] = v[i][1]; d[2] = v[i][2]; d[3] = v[i][3]; }
    asm volatile("s_waitcnt lgkmcnt(0)" ::: "memory");
}
__device__ __forceinline__ void transpose_item(const float* W, int K, int N, bf16* WT, int kind, LAS float* scr, int item, int lane) {
    const int nblk = N / 32, kb = item / nblk, nb = item % nblk, k0 = 64 * kb, n0 = 32 * nb;
    cv_load_tile(W, N, k0, n0, scr, lane);
    const int c = lane & 7;
#pragma unroll
    for (int j = 0; j < 4; ++j) { const int n = (lane >> 3) + 8 * j; const LAS float* s = scr + (8 * c) * 33 + n;
        u32x4 o; o.x = pk2(s[0 * 33], s[1 * 33]); o.y = pk2(s[2 * 33], s[3 * 33]); o.z = pk2(s[4 * 33], s[5 * 33]); o.w = pk2(s[6 * 33], s[7 * 33]);
        *(u32x4*)((unsigned char*)WT + blk_off(dst_row(kind, n0 + n), 2 * (k0 + 8 * c), 2 * K)) = o; }
    asm volatile("s_waitcnt lgkmcnt(0)" ::: "memory");
}
__device__ __forceinline__ void transpose_item_fp8(const float* W, int K, int N, unsigned char* W8, LAS float* scr, int item, int lane) {
    const int nblk = N / 32, kb = item / nblk, nb = item % nblk, k0 = 64 * kb, n0 = 32 * nb;
    cv_load_tile(W, N, k0, n0, scr, lane);
    const int c = lane & 7;
#pragma unroll
    for (int j = 0; j < 4; ++j) { const int n = (lane >> 3) + 8 * j; const LAS float* s = scr + (8 * c) * 33 + n;
        unsigned lo = 0u, hi = 0u;
        lo = __builtin_amdgcn_cvt_pk_fp8_f32(s[0 * 33] * 64.f, s[1 * 33] * 64.f, lo, false); lo = __builtin_amdgcn_cvt_pk_fp8_f32(s[2 * 33] * 64.f, s[3 * 33] * 64.f, lo, true);
        hi = __builtin_amdgcn_cvt_pk_fp8_f32(s[4 * 33] * 64.f, s[5 * 33] * 64.f, hi, false); hi = __builtin_amdgcn_cvt_pk_fp8_f32(s[6 * 33] * 64.f, s[7 * 33] * 64.f, hi, true);
        u32x2 o; o.x = lo; o.y = hi;
        *(u32x2*)(W8 + blk_off(dst_row(0, n0 + n) - GATE_OFF, k0 + 8 * c, K)) = o; }
    asm volatile("s_waitcnt lgkmcnt(0)" ::: "memory");
}
constexpr int CV_WIN = (DM / 64) * (INW / 32), CV_BR1 = (MIXW / 64) * (DM / 32), CV_WO = (DM / 64) * (DM / 32), CV_W1 = (DM / 64) * (2 * DFF / 32), CV_W2 = (DFF / 64) * (DM / 32);
constexpr int CV_TOTAL = CV_WIN + 4 * CV_BR1 + CV_WO + CV_W1 + CV_W2;
constexpr int CV_SCR_OFF = 73728;
__device__ __forceinline__ void convert_weights(Frame& F, int l, int lo, int hi, int w0, int nw) {
    LAS float* scr = (LAS float*)(F.lds + CV_SCR_OFF + F.wave * 8448);
    const int gw = (F.c - w0) * NWAVES + F.wave, NGW = nw * NWAVES;
    for (int it = lo + gw; it < hi; it += NGW) {
        int r = it;
        if (r < CV_WIN) { if ((r % (INW / 32)) * 32 >= GATE_OFF) transpose_item_fp8(F.in[7] + (size_t)l * DM * INW, DM, INW, F.ws + WS_WIN + (size_t)GATE_OFF * DM * 2, scr, r, F.lane);
            else transpose_item(F.in[7] + (size_t)l * DM * INW, DM, INW, (bf16*)(F.ws + WS_WIN), 0, scr, r, F.lane); continue; } r -= CV_WIN;
        if (r < 4 * CV_BR1) { const int n = r / CV_BR1; transpose_item(F.in[12] + (size_t)(l * 4 + n) * MIXW * DM, MIXW, DM, (bf16*)(F.ws + WS_WBR) + (size_t)n * DM * MIXW, 1, scr, r % CV_BR1, F.lane); continue; } r -= 4 * CV_BR1;
        if (r < CV_WO) { transpose_item(F.in[13] + (size_t)l * DM * DM, DM, DM, (bf16*)(F.ws + WS_WOUT), 3, scr, r, F.lane); continue; } r -= CV_WO;
        if (r < CV_W1) { transpose_item(F.in[14] + (size_t)l * DM * 2 * DFF, DM, 2 * DFF, (bf16*)(F.ws + WS_W1), 2, scr, r, F.lane); continue; } r -= CV_W1;
        transpose_item(F.in[15] + (size_t)l * DFF * DM, DFF, DM, (bf16*)(F.ws + WS_W2), 3, scr, r, F.lane);
    }
}

__device__ __forceinline__ void p0_body(Frame& F) {
    LAS float* sc = (LAS float*)F.lds;
    for (int idx = F.tid; idx < NCOND * DM; idx += NTHR) { const int j = idx >> 11, k = idx & (DM - 1); const float v = (j < NB) ? F.in[1][j * DM + k] : F.in[3][k]; sc[idx] = v / (1.f + expf(-v)); }
    __syncthreads();
    const int gw = F.c * NWAVES + F.wave, NGW = F.G * NWAVES;
    float* modp = (float*)(F.ws + WS_MODP);
    for (int it = gw; it < DEPTH * 48 * 8; it += NGW) {
        const int l = it / 384, r = it % 384, cb = r >> 3, ks = r & 7, n = cb * 256 + 4 * F.lane;
        f32x4 acc[NCOND];
#pragma unroll
        for (int j = 0; j < NCOND; ++j) acc[j] = (f32x4){0.f, 0.f, 0.f, 0.f};
        const float* wp = F.in[4] + ((size_t)l * DM + ks * 256) * ADAW + n;
        for (int k = 0; k < 256; k += 4) {
            f32x4 w[4];
#pragma unroll
            for (int kk = 0; kk < 4; ++kk) w[kk] = *(const f32x4*)(wp + (size_t)(k + kk) * ADAW);
#pragma unroll
            for (int kk = 0; kk < 4; ++kk)
#pragma unroll
                for (int j = 0; j < NCOND; ++j) acc[j] += w[kk] * sc[j * DM + ks * 256 + k + kk];
        }
#pragma unroll
        for (int j = 0; j < NCOND; ++j) *(f32x4*)(modp + ((size_t)((l * 8 + ks) * NCOND + j)) * ADAW + n) = acc[j];
    }
    convert_weights(F, 0, 0, F.G == 256 ? CV_WIN : CV_TOTAL, 0, F.G);
    __syncthreads();
    const int gt = F.c * NTHR + F.tid, NGT = F.G * NTHR;
    float* rope = (float*)(F.ws + WS_TAB);
    for (int idx = gt; idx < 64 * 32; idx += NGT) { const int pos = idx >> 5, j = idx & 31; const float fr = powf(10000.f, -(float)(2 * j) / 64.f); const float a = (float)pos * fr; rope[2 * idx] = cosf(a); rope[2 * idx + 1] = sinf(a); }
    LAS float* ct = (LAS float*)F.lds;
    for (int i = F.tid; i < 4096; i += NTHR) ct[i] = cospif((float)i * (1.f / 2048.f));
    __syncthreads();
    bf16* dl = (bf16*)(F.ws + WS_DFTL);
    for (int idx = gt; idx < 4096 * 512; idx += NGT) { const int k = idx >> 9, j8 = (idx & 511) * 8; const int tb = j8 & 2047; const bool sn = j8 >= 2048;
        float v[8];
#pragma unroll
        for (int e = 0; e < 8; ++e) { const int t = tb + e; v[e] = !sn ? ct[(k * t) & 4095] : (t == 0 ? ct[(k * 2048) & 4095] : ct[(k * t + 1024) & 4095]); }
        u32x4 o; o.x = pk2(v[0], v[1]); o.y = pk2(v[2], v[3]); o.z = pk2(v[4], v[5]); o.w = pk2(v[6], v[7]);
        *(u32x4*)(dl + (size_t)k * 4096 + j8) = o; }
    bf16* dm = (bf16*)(F.ws + WS_TAB + 65536);
    for (int idx = gt; idx < 256 * 128; idx += NGT) { const int cp = idx >> 7, c = idx & 127; const int m = (c * (cp & 127)) & 127; dm[idx] = (bf16)f2bf(ct[(m * 32 + (cp >= 128 ? 3072 : 0)) & 4095]); }
    bf16* dc = (bf16*)(F.ws + WS_DFTC);
    for (int idx = gt; idx < 256 * 64; idx += NGT) { const int k = idx >> 6, t8 = (idx & 63) * 8; const int tb = t8 & 255, ph = (t8 >= 256) ? 1024 : 0;
        float v[8];
#pragma unroll
        for (int e = 0; e < 8; ++e) v[e] = ct[((((k * (tb + e)) & 255) << 4) + ph) & 4095];
        u32x4 o; o.x = pk2(v[0], v[1]); o.y = pk2(v[2], v[3]); o.z = pk2(v[4], v[5]); o.w = pk2(v[6], v[7]);
        *(u32x4*)(dc + (size_t)k * 512 + t8) = o; }
}
__device__ __forceinline__ void p0b_body(Frame& F) {
    const int gt = F.c * NTHR + F.tid, NGT = F.G * NTHR;
    const float* modp = (const float*)(F.ws + WS_MODP); float* mod = (float*)(F.ws + WS_MOD);
    for (int idx = gt; idx < DEPTH * NCOND * ADAW; idx += NGT) { const int n = idx % ADAW, lj = idx / ADAW, j = lj % NCOND, l = lj / NCOND;
        float s = F.in[5][l * ADAW + n];
#pragma unroll
        for (int ks = 0; ks < 8; ++ks) s += modp[((size_t)((l * 8 + ks) * NCOND + j)) * ADAW + n];
        mod[idx] = s; }
}

struct RowPass {
    const float* xl_in; const float* xc_in; float* xl_out; float* xc_out;
    const bf16* Y;
    const float* gy; int gate_off;
    const float* gx; int shift_off, scale_off; int lnext;
    int l; bool do_ctx; bf16* HX;
    unsigned char* HX8;
    const float* part;
    const bf16* Y0; const float* gy0; int gate0_off;
};
template <bool PF> __device__ __forceinline__ void row_block(Frame& F, const RowPass& P, int row0, int nrows, int cond, const float* xin, float* xout, int xrow0) {
    LAS float* V = (LAS float*)F.lds;
    const float* mod = (const float*)(F.ws + WS_MOD);
    const bool pre = P.Y0 != nullptr && row0 < RL;
    __syncthreads();
    for (int i = F.tid; i < DM; i += NTHR) {
        V[i] = P.Y ? mod[((size_t)(P.l * NCOND + cond)) * ADAW + P.gate_off + i] * P.gy[i] : 0.f;
        if (pre) V[3 * DM + i] = mod[((size_t)(P.l * NCOND + cond)) * ADAW + P.gate0_off + i] * P.gy0[i];
        if (P.lnext >= 0) { const float* mn = mod + ((size_t)(P.lnext * NCOND + cond)) * ADAW; V[DM + i] = P.gx[i] * (1.f + mn[P.scale_off + i]); V[2 * DM + i] = mn[P.shift_off + i]; }
    }
    __syncthreads();
    const bool ypl = P.Y != nullptr && !(P.part && row0 >= RL);
    f32x4 xn[8]; u32x2 yn[8];
#pragma unroll
    for (int j = 0; j < 8; ++j) { xn[j] = (f32x4){0.f, 0.f, 0.f, 0.f}; yn[j] = (u32x2){0u, 0u}; }
#define RB_LOAD(rw) do { const int rw_ = __builtin_amdgcn_readfirstlane(rw); const size_t xo_ = (size_t)(rw_ - xrow0) * DM; \
        _Pragma("unroll") for (int j = 0; j < 8; ++j) xn[j] = *(const f32x4*)(xin + xo_ + j * 256 + 4 * F.lane); \
        if (ypl) { _Pragma("unroll") for (int j = 0; j < 8; ++j) yn[j] = *(const u32x2*)(P.Y + (size_t)rw_ * DM + j * 256 + 4 * F.lane); } } while (0)
    if (PF) { if (F.wave < nrows) RB_LOAD(row0 + F.wave); }
    for (int rr = F.wave; rr < nrows; rr += NWAVES) {
        const int row = row0 + rr; const size_t xo = (size_t)(row - xrow0) * DM;
        if (!PF) RB_LOAD(row);
        f32x4 xv[8];
#pragma unroll
        for (int j = 0; j < 8; ++j) xv[j] = xn[j];
        if (pre) {
            f32x4 yv[8]; float ss = 0.f;
#pragma unroll
            for (int j = 0; j < 8; ++j) { const u32x2 yw = *(const u32x2*)(P.Y0 + (size_t)row * DM + j * 256 + 4 * F.lane); yv[j] = (f32x4){bflo(yw.x), bfhi(yw.x), bflo(yw.y), bfhi(yw.y)}; }
#pragma unroll
            for (int j = 0; j < 8; ++j) ss += (yv[j][0] * yv[j][0] + yv[j][1] * yv[j][1]) + (yv[j][2] * yv[j][2] + yv[j][3] * yv[j][3]);
            const float rstd = __builtin_amdgcn_rsqf(wave_sum(ss) * (1.f / DM) + EPS);
#pragma unroll
            for (int j = 0; j < 8; ++j) { const f32x4 va = *(const LAS f32x4*)(V + 3 * DM + j * 256 + 4 * F.lane); xv[j] += va * (yv[j] * rstd); }
        }
        if (P.Y) {
            f32x4 yv[8]; float ss = 0.f;
            if (P.part && row >= RL) {
#pragma unroll
                for (int j = 0; j < 8; ++j) { const float* pp = P.part + (size_t)(row - RL) * DM + j * 256 + 4 * F.lane;
                    yv[j] = (*(const f32x4*)pp + *(const f32x4*)(pp + (size_t)RC * DM)) + (*(const f32x4*)(pp + (size_t)2 * RC * DM) + *(const f32x4*)(pp + (size_t)3 * RC * DM)); }
            } else {
#pragma unroll
                for (int j = 0; j < 8; ++j) { const u32x2 yw = yn[j]; yv[j] = (f32x4){bflo(yw.x), bfhi(yw.x), bflo(yw.y), bfhi(yw.y)}; }
            }
#pragma unroll
            for (int j = 0; j < 8; ++j) ss += (yv[j][0] * yv[j][0] + yv[j][1] * yv[j][1]) + (yv[j][2] * yv[j][2] + yv[j][3] * yv[j][3]);
            const float rstd = __builtin_amdgcn_rsqf(wave_sum(ss) * (1.f / DM) + EPS);
            if (PF) { if (rr + NWAVES < nrows) RB_LOAD(row + NWAVES); }
#pragma unroll
            for (int j = 0; j < 8; ++j) { const f32x4 va = *(const LAS f32x4*)(V + j * 256 + 4 * F.lane);
                xv[j] += va * (yv[j] * rstd);
                if (xout) *(f32x4*)(xout + xo + j * 256 + 4 * F.lane) = xv[j]; }
        } else if (PF) { if (rr + NWAVES < nrows) RB_LOAD(row + NWAVES); }
        if (P.lnext >= 0) {
            float ss = 0.f;
#pragma unroll
            for (int j = 0; j < 8; ++j) ss += (xv[j][0] * xv[j][0] + xv[j][1] * xv[j][1]) + (xv[j][2] * xv[j][2] + xv[j][3] * xv[j][3]);
            const float rstd = __builtin_amdgcn_rsqf(wave_sum(ss) * (1.f / DM) + EPS);
#pragma unroll
            for (int j = 0; j < 8; ++j) { const f32x4 vb = *(const LAS f32x4*)(V + DM + j * 256 + 4 * F.lane), vc = *(const LAS f32x4*)(V + 2 * DM + j * 256 + 4 * F.lane);
                const f32x4 h = xv[j] * rstd * vb + vc; u32x2 o; o.x = pk2(h[0], h[1]); o.y = pk2(h[2], h[3]);
                *(u32x2*)(P.HX + (size_t)row * DM + j * 256 + 4 * F.lane) = o;
                if (P.HX8) { unsigned w8 = 0u; w8 = __builtin_amdgcn_cvt_pk_fp8_f32(h[0], h[1], w8, false); w8 = __builtin_amdgcn_cvt_pk_fp8_f32(h[2], h[3], w8, true); *(unsigned*)(P.HX8 + (size_t)row * DM + j * 256 + 4 * F.lane) = w8; } }
        }
    }
}
#undef RB_LOAD
__device__ __forceinline__ void row_pass(Frame& F, const RowPass& P) {
    for (int blk = F.c; blk < RL / 128; blk += F.G) row_block<true>(F, P, blk * 128, 128, (blk * 128) / SEQ, P.xl_in, P.xl_out, 0);
    if (P.do_ctx) for (int blk = F.c; blk < RC / 8; blk += F.G) row_block<false>(F, P, RL + blk * 8, 8, NB, P.xc_in, P.xc_out, RL);
    __syncthreads();
}

__device__ __forceinline__ void conv_body(Frame& F, int l, int nrows) {
    const bf16* P = (const bf16*)(F.ws + WS_PROJ); bf16* BR = (bf16*)(F.ws + WS_BUFB); const float* cw = F.in[9] + (size_t)l * 3 * MIXW;
    const int gt = F.c * NTHR + F.tid, NGT = F.G * NTHR;
    for (int idx = gt; idx < nrows * 64; idx += NGT) {
        const int r = idx >> 6, c8 = (idx & 63) * 8; bool hl, hr;
        if (r < RL) { const int col = r & 63; hl = col > 0; hr = col < 63; } else { const int t = (r - RL) & (CTXL - 1); hl = t > 0; hr = t < CTXL - 1; }
        const bf16* pr = P + (size_t)r * INW;
        float y[3][8];
#pragma unroll
        for (int k = 0; k < 3; ++k) { const bool ok = (k == 1) || (k == 0 ? hl : hr);
            if (ok) { const bf16* q = pr + (ptrdiff_t)(k - 1) * INW; const u32x4 cwd = *(const u32x4*)(q + SCC_OFF + c8), xw = *(const u32x4*)(q + SCX_OFF + c8);
                y[k][0] = bflo(cwd.x) * bflo(xw.x); y[k][1] = bfhi(cwd.x) * bfhi(xw.x); y[k][2] = bflo(cwd.y) * bflo(xw.y); y[k][3] = bfhi(cwd.y) * bfhi(xw.y);
                y[k][4] = bflo(cwd.z) * bflo(xw.z); y[k][5] = bfhi(cwd.z) * bfhi(xw.z); y[k][6] = bflo(cwd.w) * bflo(xw.w); y[k][7] = bfhi(cwd.w) * bfhi(xw.w); }
            else {
#pragma unroll
                for (int e = 0; e < 8; ++e) y[k][e] = 0.f; } }
        const u32x4 bw = *(const u32x4*)(pr + SCB_OFF + c8);
        const float bv[8] = {bflo(bw.x), bfhi(bw.x), bflo(bw.y), bfhi(bw.y), bflo(bw.z), bfhi(bw.z), bflo(bw.w), bfhi(bw.w)};
        float o[8];
#pragma unroll
        for (int e = 0; e < 8; ++e) o[e] = bv[e] * (cw[c8 + e] * y[0][e] + cw[MIXW + c8 + e] * y[1][e] + cw[2 * MIXW + c8 + e] * y[2][e]);
        u32x4 ow; ow.x = pk2(o[0], o[1]); ow.y = pk2(o[2], o[3]); ow.z = pk2(o[4], o[5]); ow.w = pk2(o[6], o[7]);
        *(u32x4*)(BR + (size_t)r * DM + 3 * MIXW + c8) = ow;
    }
}
__device__ __forceinline__ void scan_body(Frame& F, int l) {
    const bf16* DS = (const bf16*)(F.ws + WS_BUFA); bf16* ST = (bf16*)(F.ws + WS_ST);
    const int gt = F.c * NTHR + F.tid, NGT = F.G * NTHR;
    for (int idx = gt; idx < NB * NGRP * 2 * (GD * GD / 4); idx += NGT) {
        const int e4 = (idx & (GD * GD / 4 - 1)) * 4, bhd = __builtin_amdgcn_readfirstlane(idx >> 12), dir = bhd & 1, h = (bhd >> 1) & 3;
        const float cd = __expf(F.in[8][(l * 2 + dir) * NGRP + h] * 128.f);
        const size_t base = (size_t)bhd * NCH * (GD * GD);
        f32x4 s = (f32x4){0.f, 0.f, 0.f, 0.f};
#pragma unroll
        for (int hb = 0; hb < 1; ++hb) {
            u32x2 dw[NCH];
#pragma unroll
            for (int k = 0; k < NCH; ++k) { const int st = k, ci = (dir == 0) ? st : (st < 2 ? 1 - st : NCH + 1 - st); dw[k] = *(const u32x2*)(DS + base + (size_t)ci * (GD * GD) + e4); }
#pragma unroll
            for (int k = 0; k < NCH; ++k) {
                const int st = k, ci = (dir == 0) ? st : (st < 2 ? 1 - st : NCH + 1 - st);
                u32x2 o; o.x = pk2(s[0], s[1]); o.y = pk2(s[2], s[3]); *(u32x2*)(ST + base + (size_t)ci * (GD * GD) + e4) = o;
                const f32x4 d = (f32x4){bflo(dw[k].x), bfhi(dw[k].x), bflo(dw[k].y), bfhi(dw[k].y)};
                s = s * cd + d;
            }
        }
    }
}

typedef short s16x4 __attribute__((ext_vector_type(4)));
typedef short bf16x8 __attribute__((ext_vector_type(8)));
__device__ __forceinline__ unsigned lds_addr(const LAS void* p) { return (unsigned)(size_t)p; }
template <int PITCH> __device__ __forceinline__ void load_tile_p(LAS bf16* dst, const bf16* src, size_t ld, int tid) {
#pragma unroll
    for (int i = 0; i < 4; ++i) { const int idx = tid + 512 * i, row = idx >> 4, ch = idx & 15;
        const u32x4 v = *(const u32x4*)(src + (size_t)row * ld + ch * 8); *(LAS u32x4*)(dst + row * PITCH + ch * 8) = v; }
}
template <int OFF0, int OFF1> __device__ __forceinline__ void tr_pair(s16x4& lo, s16x4& hi, unsigned addr) {
    asm volatile("ds_read_b64_tr_b16 %0, %2 offset:%3\n\tds_read_b64_tr_b16 %1, %2 offset:%4" : "=&v"(lo), "=&v"(hi) : "v"(addr), "i"(OFF0), "i"(OFF1) : "memory");
}
template <int R2> __device__ __forceinline__ void tr_frags8(s16x4 (&lo)[8], s16x4 (&hi)[8], unsigned addr) {
    tr_pair<0, R2>(lo[0], hi[0], addr); tr_pair<32, 32 + R2>(lo[1], hi[1], addr); tr_pair<64, 64 + R2>(lo[2], hi[2], addr); tr_pair<96, 96 + R2>(lo[3], hi[3], addr);
    tr_pair<128, 128 + R2>(lo[4], hi[4], addr); tr_pair<160, 160 + R2>(lo[5], hi[5], addr); tr_pair<192, 192 + R2>(lo[6], hi[6], addr); tr_pair<224, 224 + R2>(lo[7], hi[7], addr);
    asm volatile("s_waitcnt lgkmcnt(0)" ::: "memory"); __builtin_amdgcn_sched_barrier(0);
}
#define FRAG8(lo, hi, i) __builtin_shufflevector(lo[i], hi[i], 0, 1, 2, 3, 4, 5, 6, 7)
#define MFMA16(a, b, c) __builtin_amdgcn_mfma_f32_16x16x32_bf16(a, b, c, 0, 0, 0)

__device__ __forceinline__ void ret_item_mfma(Frame& F, int l, int it, bool lat_only) {
    int b, h, ci; decode_item(it, lat_only, b, h, ci);
    const bf16* P = (const bf16*)(F.ws + WS_PROJ); const int row0 = chunk_row(b, ci);
    LAS bf16* QS = (LAS bf16*)F.lds; LAS bf16* KS = (LAS bf16*)(F.lds + 34816); LAS bf16* VS = (LAS bf16*)(F.lds + 71680); LAS bf16* SF = (LAS bf16*)(F.lds + 108544); LAS bf16* SB = KS;
    const float lgf = F.in[8][(l * 2 + 0) * NGRP + h], lgb = F.in[8][(l * 2 + 1) * NGRP + h];
    const bf16* ST = (const bf16*)(F.ws + WS_ST) + ((size_t)(((b * NGRP + h) * 2 + 0) * NCH + ci)) * (GD * GD);
    __syncthreads();
    load_tile_p<136>(QS, P + (size_t)row0 * INW + Q_OFF + h * GD, INW, F.tid);
    load_tile_p<136>(KS, P + (size_t)row0 * INW + K_OFF + h * GD, INW, F.tid);
    load_tile_p<144>(VS, P + (size_t)row0 * INW + V_OFF + h * GD, INW, F.tid);
    load_tile_p<144>(SF, ST, GD, F.tid);
    __syncthreads();
    int lane_ = F.lane; asm volatile("" : "+v"(lane_));
    const int w = F.wave, g = lane_ >> 4, n = lane_ & 15, q4 = n >> 2, p4 = n & 3;
    bf16x8 qf[4];
#pragma unroll
    for (int ks = 0; ks < 4; ++ks) qf[ks] = *(const LAS bf16x8*)(QS + (16 * w + n) * 136 + 32 * ks + 8 * g);
    bf16x8 pf[4];
    {
        f32x4 s[8];
#pragma unroll
        for (int jt = 0; jt < 8; ++jt) { s[jt] = (f32x4){0.f, 0.f, 0.f, 0.f};
#pragma unroll
            for (int ks = 0; ks < 4; ++ks) { const bf16x8 kf = *(const LAS bf16x8*)(KS + (16 * jt + n) * 136 + 32 * ks + 8 * g); s[jt] = MFMA16(kf, qf[ks], s[jt]); }
            if (jt & 1) __builtin_amdgcn_sched_barrier(0); }
        const int ic = 16 * w + n;
#pragma unroll
        for (int jb = 0; jb < 4; ++jb) { unsigned wds[4];
#pragma unroll
            for (int hf = 0; hf < 2; ++hf) { float v[4];
#pragma unroll
                for (int r = 0; r < 4; ++r) { const int d = ic - (16 * (2 * jb + hf) + 4 * g + r); const float e = __expf(((d > 0) ? lgf : lgb) * fabsf((float)d)); v[r] = s[2 * jb + hf][r] * ((d == 0) ? 2.f : e); }
                wds[2 * hf] = pk2(v[0], v[1]); wds[2 * hf + 1] = pk2(v[2], v[3]); }
            pf[jb] = __builtin_bit_cast(bf16x8, (u32x4){wds[0], wds[1], wds[2], wds[3]}); }
    }
    __syncthreads();
    load_tile_p<144>(SB, ST + (size_t)NCH * GD * GD, GD, F.tid);
    f32x4 o[8], cf[8], cb[8];
#pragma unroll
    for (int e = 0; e < 8; ++e) { o[e] = (f32x4){0.f, 0.f, 0.f, 0.f}; cf[e] = o[e]; cb[e] = o[e]; }
    {
        const unsigned va = lds_addr(VS) + (unsigned)((4 * g + q4) * 288 + p4 * 8);
#pragma unroll
        for (int jb = 0; jb < 4; ++jb) { s16x4 lo[8], hi[8]; tr_frags8<16 * 288>(lo, hi, va + jb * 32 * 288);
#pragma unroll
            for (int e = 0; e < 8; ++e) o[e] = MFMA16(FRAG8(lo, hi, e), pf[jb], o[e]); }
        const unsigned sa = lds_addr(SF) + (unsigned)((8 * g + q4) * 288 + p4 * 8);
#pragma unroll
        for (int ks = 0; ks < 4; ++ks) { s16x4 lo[8], hi[8]; tr_frags8<4 * 288>(lo, hi, sa + ks * 32 * 288);
#pragma unroll
            for (int e = 0; e < 8; ++e) cf[e] = MFMA16(FRAG8(lo, hi, e), qf[ks], cf[e]); }
    }
    __syncthreads();
    {
        const unsigned sa = lds_addr(SB) + (unsigned)((8 * g + q4) * 288 + p4 * 8);
#pragma unroll
        for (int ks = 0; ks < 4; ++ks) { s16x4 lo[8], hi[8]; tr_frags8<4 * 288>(lo, hi, sa + ks * 32 * 288);
#pragma unroll
            for (int e = 0; e < 8; ++e) cb[e] = MFMA16(FRAG8(lo, hi, e), qf[ks], cb[e]); }
    }
    bf16* BR = (bf16*)(F.ws + WS_BUFB);
    {
        const int i = 16 * w + n; const float wf = __expf(lgf * (float)(i + 1)), wb = __expf(lgb * (float)(128 - i));
        float ss = 0.f;
#pragma unroll
        for (int e = 0; e < 8; ++e) { o[e] = o[e] + wf * cf[e] + wb * cb[e]; ss += (o[e][0] * o[e][0] + o[e][1] * o[e][1]) + (o[e][2] * o[e][2] + o[e][3] * o[e][3]); }
        ss += __shfl_xor(ss, 16); ss += __shfl_xor(ss, 32);
        const float rstd = __builtin_amdgcn_rsqf(ss * (1.f / GD) + EPS); const size_t row = (size_t)(row0 + i);
        u32x2 gw[8];
#pragma unroll
        for (int e = 0; e < 8; ++e) gw[e] = *(const u32x2*)(P + row * INW + G_OFF + h * GD + 16 * e + 4 * g);
#pragma unroll
        for (int e = 0; e < 8; ++e) { u32x2 ov; ov.x = pk2(bflo(gw[e].x) * o[e][0] * rstd, bfhi(gw[e].x) * o[e][1] * rstd); ov.y = pk2(bflo(gw[e].y) * o[e][2] * rstd, bfhi(gw[e].y) * o[e][3] * rstd);
            *(u32x2*)(BR + row * DM + h * GD + 16 * e + 4 * g) = ov; }
    }
}

constexpr int DFTM_LDS = 0, ZS_LDS = 69632;
__device__ __forceinline__ void chdft_stage_m(Frame& F) {
    const bf16* M = (const bf16*)(F.ws + WS_TAB + 65536); LAS bf16* MS = (LAS bf16*)(F.lds + DFTM_LDS);
    __syncthreads();
#pragma unroll
    for (int i = 0; i < 8; ++i) { const int idx = F.tid + 512 * i, row = idx >> 4, ch = idx & 15; *(LAS u32x4*)(MS + row * 136 + ch * 8) = *(const u32x4*)(M + row * GD + ch * 8); }
    __syncthreads();
}
constexpr int ZP_LDS = 69632, ZM_LDS = 69632 + 34816, SPC_LDS = 69632 + 2 * 34816;
__device__ __forceinline__ void chdft_ctx_item(Frame& F, int r) {
    const int b = r >> 3, g_ = (r >> 1) & 3, ci = r & 1;
    const bf16* P = (const bf16*)(F.ws + WS_PROJ); const int row0 = chunk_row(b, ci);
    LAS bf16* MS = (LAS bf16*)(F.lds + DFTM_LDS); LAS bf16* ZS = (LAS bf16*)(F.lds + ZS_LDS);
    int tid_ = F.tid; asm volatile("" : "+v"(tid_));
    __syncthreads();
    load_tile_p<136>(ZS, P + (size_t)row0 * INW + F_OFF + g_ * GD, INW, tid_);
    __syncthreads();
    const int lane = tid_ & 63, w = F.wave, g = lane >> 4, n = lane & 15;
    bf16x8 zf[4];
#pragma unroll
    for (int ks = 0; ks < 4; ++ks) zf[ks] = *(const LAS bf16x8*)(ZS + (16 * w + n) * 136 + 32 * ks + 8 * g);
    const int t0 = ci * 128, T = CTXL;
    bf16* Z = (bf16*)(F.ws + WS_ZCT) + (size_t)NB * 512 * 8192;
#pragma unroll
    for (int half = 0; half < 2; ++half) {
        f32x4 acc[8];
#pragma unroll
        for (int ct = 0; ct < 8; ++ct) { acc[ct] = (f32x4){0.f, 0.f, 0.f, 0.f};
#pragma unroll
            for (int ks = 0; ks < 4; ++ks) { const bf16x8 mf = *(const LAS bf16x8*)(MS + (128 * half + 16 * ct + n) * 136 + 32 * ks + 8 * g); acc[ct] = MFMA16(zf[ks], mf, acc[ct]); } }
#pragma unroll
        for (int ct = 0; ct < 8; ++ct) { const int cp = g_ * GD + 16 * ct + n; bf16* dst = Z + ((size_t)(b * 512 + cp) * 2 + half) * T + t0 + 16 * w + 4 * g;
            u32x2 o; o.x = pk2(acc[ct][0], acc[ct][1]); o.y = pk2(acc[ct][2], acc[ct][3]); *(u32x2*)dst = o; }
    }
}

struct DsRegs { u32x4 k[4], v[4]; };
__device__ __forceinline__ void ds_load(Frame& F, int it, DsRegs& R) {
    int b, h, ci; decode_item(it, false, b, h, ci);
    int tid_ = F.tid; asm volatile("" : "+v"(tid_));
    const bf16* P = (const bf16*)(F.ws + WS_PROJ) + (size_t)chunk_row(b, ci) * INW + h * GD;
#pragma unroll
    for (int i = 0; i < 4; ++i) { const int idx = tid_ + 512 * i, row = idx >> 4, ch = idx & 15; R.k[i] = *(const u32x4*)(P + (size_t)row * INW + K_OFF + ch * 8); R.v[i] = *(const u32x4*)(P + (size_t)row * INW + V_OFF + ch * 8); }
}
__device__ __forceinline__ void ds_stage(Frame& F, int l, int it, const DsRegs& R) {
    int b, h, ci; decode_item(it, false, b, h, ci);
    int tid_ = F.tid; asm volatile("" : "+v"(tid_));
    LAS bf16* KS = (LAS bf16*)F.lds; LAS bf16* VF = (LAS bf16*)(F.lds + 36864); LAS bf16* VB = (LAS bf16*)(F.lds + 73728);
    const float lgf = F.in[8][(l * 2 + 0) * NGRP + h], lgb = F.in[8][(l * 2 + 1) * NGRP + h];
#pragma unroll
    for (int i = 0; i < 4; ++i) { const int idx = tid_ + 512 * i, row = idx >> 4, ch = idx & 15; const u32x4 v = R.v[i];
        *(LAS u32x4*)(KS + row * 144 + ch * 8) = R.k[i];
        const float wf = __expf(lgf * (float)(127 - row)), wb = __expf(lgb * (float)row);
        const float x[8] = {bflo(v.x), bfhi(v.x), bflo(v.y), bfhi(v.y), bflo(v.z), bfhi(v.z), bflo(v.w), bfhi(v.w)};
        u32x4 a, c; a.x = pk2(x[0] * wf, x[1] * wf); a.y = pk2(x[2] * wf, x[3] * wf); a.z = pk2(x[4] * wf, x[5] * wf); a.w = pk2(x[6] * wf, x[7] * wf);
        c.x = pk2(x[0] * wb, x[1] * wb); c.y = pk2(x[2] * wb, x[3] * wb); c.z = pk2(x[4] * wb, x[5] * wb); c.w = pk2(x[6] * wb, x[7] * wb);
        *(LAS u32x4*)(VF + row * 144 + ch * 8) = a; *(LAS u32x4*)(VB + row * 144 + ch * 8) = c; }
}
__device__ __forceinline__ void ds_compute(Frame& F, int it) {
    int b, h, ci; decode_item(it, false, b, h, ci);
    int lane_ = F.lane; asm volatile("" : "+v"(lane_));
    LAS bf16* KS = (LAS bf16*)F.lds; LAS bf16* VF = (LAS bf16*)(F.lds + 36864); LAS bf16* VB = (LAS bf16*)(F.lds + 73728);
    const int lane = lane_, w = F.wave, g = lane >> 4, n = lane & 15, q4 = n >> 2, p4 = n & 3;
    f32x4 af[8], ab[8];
#pragma unroll
    for (int e = 0; e < 8; ++e) { af[e] = (f32x4){0.f, 0.f, 0.f, 0.f}; ab[e] = af[e]; }
    const unsigned ka = lds_addr(KS) + (unsigned)((8 * g + q4) * 288 + (16 * w + 4 * p4) * 2);
    const unsigned fa = lds_addr(VF) + (unsigned)((8 * g + q4) * 288 + p4 * 8), ba = lds_addr(VB) + (unsigned)((8 * g + q4) * 288 + p4 * 8);
#pragma unroll
    for (int ks = 0; ks < 4; ++ks) {
        s16x4 klo, khi; tr_pair<0, 4 * 288>(klo, khi, ka + ks * 32 * 288);
        { s16x4 lo[8], hi[8]; tr_frags8<4 * 288>(lo, hi, fa + ks * 32 * 288); const bf16x8 kf = __builtin_shufflevector(klo, khi, 0, 1, 2, 3, 4, 5, 6, 7);
#pragma unroll
          for (int e = 0; e < 8; ++e) af[e] = MFMA16(FRAG8(lo, hi, e), kf, af[e]); }
        { s16x4 lo[8], hi[8]; tr_frags8<4 * 288>(lo, hi, ba + ks * 32 * 288); const bf16x8 kf = __builtin_shufflevector(klo, khi, 0, 1, 2, 3, 4, 5, 6, 7);
#pragma unroll
          for (int e = 0; e < 8; ++e) ab[e] = MFMA16(FRAG8(lo, hi, e), kf, ab[e]); }
    }
    bf16* DS = (bf16*)(F.ws + WS_BUFA);
    bf16* df = DS + ((size_t)(((b * NGRP + h) * 2 + 0) * NCH + ci)) * (GD * GD); bf16* db = df + (size_t)NCH * GD * GD;
#pragma unroll
    for (int e = 0; e < 8; ++e) { const int o = (16 * w + n) * GD + 16 * e + 4 * g;
        u32x2 x, y; x.x = pk2(af[e][0], af[e][1]); x.y = pk2(af[e][2], af[e][3]); y.x = pk2(ab[e][0], ab[e][1]); y.y = pk2(ab[e][2], ab[e][3]);
        *(u32x2*)(df + o) = x; *(u32x2*)(db + o) = y; }
}
__device__ __forceinline__ void ds_pipeline(Frame& F, int l) {
    DsRegs R; int it = F.c; if (it < 1088) ds_load(F, it, R);
    while (it < 1088) {
        __syncthreads(); ds_stage(F, l, it, R); __syncthreads();
        const int nit = it + F.G; if (nit < 1088) ds_load(F, nit, R);
        ds_compute(F, it); it = nit;
    }
}
struct SguRegs { u32x4 v[4]; u32x2 u[8]; };
__device__ __forceinline__ void sgu_decode(int it, bool lat_only, int& b, int& g_, int& ci) { g_ = it & 3; const int r = it >> 2; if (lat_only) { b = r >> 5; ci = 2 + (r & 31); } else { b = r / NCH; ci = r % NCH; } }
__device__ __forceinline__ void sgu_load(Frame& F, int it, bool lat_only, SguRegs& R) {
    int b, g_, ci; sgu_decode(it, lat_only, b, g_, ci);
    int tid_ = F.tid; asm volatile("" : "+v"(tid_));
    const bf16* P = (const bf16*)(F.ws + WS_PROJ) + (size_t)chunk_row(b, ci) * INW + g_ * GD;
    { const int p = tid_ >> 2, qd = tid_ & 3; const bf16* src = P + (size_t)p * INW + VS_OFF + qd * 32;
#pragma unroll
      for (int i = 0; i < 4; ++i) R.v[i] = *(const u32x4*)(src + 8 * i); }
    { const int lane = tid_ & 63, g = lane >> 4, n = lane & 15; const bf16* src = P + (size_t)(16 * F.wave + n) * INW + U_OFF + 4 * g;
#pragma unroll
      for (int e = 0; e < 8; ++e) R.u[e] = *(const u32x2*)(src + 16 * e); }
}
__device__ __forceinline__ void sgu_stage_w(Frame& F, int l, int g_) {
    int tid_ = F.tid; asm volatile("" : "+v"(tid_));
    LAS bf16* WSM = (LAS bf16*)F.lds; const float* wsg = F.in[10] + (size_t)(l * NGRP + g_) * GD * GD;
#pragma unroll
    for (int i = 0; i < 8; ++i) { const int idx = tid_ + 512 * i, row = idx >> 5, ch = idx & 31; const f32x4 v = *(const f32x4*)(wsg + row * GD + ch * 4);
        u32x2 o; o.x = pk2(v[0], v[1]); o.y = pk2(v[2], v[3]); *(LAS u32x2*)(WSM + row * 136 + ch * 4) = o; }
}
__device__ __forceinline__ void sgu_stage(Frame& F, const SguRegs& R) {
    int tid_ = F.tid; asm volatile("" : "+v"(tid_));
    LAS bf16* VN = (LAS bf16*)(F.lds + 34816);
    const int p = tid_ >> 2, qd = tid_ & 3;
    float x[32];
#pragma unroll
    for (int i = 0; i < 4; ++i) { const u32x4 w = R.v[i]; x[8 * i] = bflo(w.x); x[8 * i + 1] = bfhi(w.x); x[8 * i + 2] = bflo(w.y); x[8 * i + 3] = bfhi(w.y); x[8 * i + 4] = bflo(w.z); x[8 * i + 5] = bfhi(w.z); x[8 * i + 6] = bflo(w.w); x[8 * i + 7] = bfhi(w.w); }
    float s = 0.f;
#pragma unroll
    for (int i = 0; i < 32; ++i) s += x[i];
    s += __shfl_xor(s, 1); s += __shfl_xor(s, 2); const float mu = s * (1.f / GD); float q = 0.f;
#pragma unroll
    for (int i = 0; i < 32; ++i) { x[i] -= mu; q += x[i] * x[i]; }
    q += __shfl_xor(q, 1); q += __shfl_xor(q, 2); const float rstd = __builtin_amdgcn_rsqf(q * (1.f / GD) + EPS);
#pragma unroll
    for (int i = 0; i < 4; ++i) { u32x4 o; o.x = pk2(x[8 * i] * rstd, x[8 * i + 1] * rstd); o.y = pk2(x[8 * i + 2] * rstd, x[8 * i + 3] * rstd); o.z = pk2(x[8 * i + 4] * rstd, x[8 * i + 5] * rstd); o.w = pk2(x[8 * i + 6] * rstd, x[8 * i + 7] * rstd);
        *(LAS u32x4*)(VN + p * 144 + qd * 32 + 8 * i) = o; }
}
__device__ __forceinline__ void sgu_compute(Frame& F, int l, int it, bool lat_only, const u32x2 (&uw)[8]) {
    int b, g_, ci; sgu_decode(it, lat_only, b, g_, ci);
    int lane_ = F.lane; asm volatile("" : "+v"(lane_));
    LAS bf16* WSM = (LAS bf16*)F.lds; LAS bf16* VN = (LAS bf16*)(F.lds + 34816);
    const int lane = lane_, w = F.wave, g = lane >> 4, n = lane & 15, q4 = n >> 2, p4 = n & 3;
    f32x4 acc[8];
#pragma unroll
    for (int e = 0; e < 8; ++e) acc[e] = (f32x4){0.f, 0.f, 0.f, 0.f};
    const unsigned va = lds_addr(VN) + (unsigned)((8 * g + q4) * 288 + p4 * 8);
#pragma unroll
    for (int ks = 0; ks < 4; ++ks) { const bf16x8 wf = *(const LAS bf16x8*)(WSM + (16 * w + n) * 136 + 32 * ks + 8 * g);
        s16x4 lo[8], hi[8]; tr_frags8<4 * 288>(lo, hi, va + ks * 32 * 288);
#pragma unroll
        for (int e = 0; e < 8; ++e) acc[e] = MFMA16(FRAG8(lo, hi, e), wf, acc[e]); }
    bf16* BR = (bf16*)(F.ws + WS_BUFB);
    const int q = 16 * w + n; const float bs = F.in[11][(l * NGRP + g_) * GD + q]; const size_t row = (size_t)(chunk_row(b, ci) + q);
#pragma unroll
    for (int e = 0; e < 8; ++e) { u32x2 ov; ov.x = pk2(bflo(uw[e].x) * (acc[e][0] + bs), bfhi(uw[e].x) * (acc[e][1] + bs)); ov.y = pk2(bflo(uw[e].y) * (acc[e][2] + bs), bfhi(uw[e].y) * (acc[e][3] + bs));
        *(u32x2*)(BR + row * DM + 2 * MIXW + g_ * GD + 16 * e + 4 * g) = ov; }
}
__device__ __forceinline__ void sgu_pipeline(Frame& F, int l, bool lat_only) {
    const int nit_all = lat_only ? 1024 : 1088;
    SguRegs R; int it = (F.c + 64) % F.G, wg = -1; if (it < nit_all) sgu_load(F, it, lat_only, R);
    while (it < nit_all) {
        __syncthreads();
        if ((it & 3) != wg) { wg = it & 3; sgu_stage_w(F, l, wg); }
        sgu_stage(F, R);
        u32x2 uw[8];
#pragma unroll
        for (int e = 0; e < 8; ++e) uw[e] = R.u[e];
        __syncthreads();
        const int nit = it + F.G; if (nit < nit_all) sgu_load(F, nit, lat_only, R);
        sgu_compute(F, l, it, lat_only, uw); it = nit;
    }
}
struct CdRegs { u32x4 a[4], m[4]; };
__device__ __forceinline__ void cd_load(Frame& F, int it, CdRegs& R) {
    const int b = it >> 6, g_ = (it >> 4) & 3, t0 = 128 * (it & 15);
    int tid_ = F.tid; asm volatile("" : "+v"(tid_));
    const bf16* P = (const bf16*)(F.ws + WS_PROJ) + (size_t)(b * SEQ) * INW + F_OFF + g_ * GD;
#pragma unroll
    for (int i = 0; i < 4; ++i) { const int idx = tid_ + 512 * i, row = idx >> 4, ch = idx & 15; const int t = t0 + row;
        R.a[i] = *(const u32x4*)(P + (size_t)t * INW + ch * 8);
        R.m[i] = (u32x4){0u, 0u, 0u, 0u}; if (t > 0) R.m[i] = *(const u32x4*)(P + (size_t)(SEQ - t) * INW + ch * 8); }
}
__device__ __forceinline__ void cd_stage(Frame& F, int it, const CdRegs& R) {
    const int b = it >> 6, g_ = (it >> 4) & 3, np = it & 15;
    int tid_ = F.tid; asm volatile("" : "+v"(tid_));
    LAS bf16* MS = (LAS bf16*)(F.lds + DFTM_LDS); LAS bf16* ZP = (LAS bf16*)(F.lds + ZP_LDS); LAS bf16* ZM = (LAS bf16*)(F.lds + ZM_LDS); LAS float* SPC = (LAS float*)(F.lds + SPC_LDS);
#pragma unroll
    for (int i = 0; i < 4; ++i) { const int idx = tid_ + 512 * i, row = idx >> 4, ch = idx & 15; const u32x4 a = R.a[i], m = R.m[i];
        u32x4 sp, sm;
        sp.x = pk2(bflo(a.x) + bflo(m.x), bfhi(a.x) + bfhi(m.x)); sp.y = pk2(bflo(a.y) + bflo(m.y), bfhi(a.y) + bfhi(m.y)); sp.z = pk2(bflo(a.z) + bflo(m.z), bfhi(a.z) + bfhi(m.z)); sp.w = pk2(bflo(a.w) + bflo(m.w), bfhi(a.w) + bfhi(m.w));
        sm.x = pk2(bflo(a.x) - bflo(m.x), bfhi(a.x) - bfhi(m.x)); sm.y = pk2(bflo(a.y) - bflo(m.y), bfhi(a.y) - bfhi(m.y)); sm.z = pk2(bflo(a.z) - bflo(m.z), bfhi(a.z) - bfhi(m.z)); sm.w = pk2(bflo(a.w) - bflo(m.w), bfhi(a.w) - bfhi(m.w));
        *(LAS u32x4*)(ZP + row * 136 + ch * 8) = sp; *(LAS u32x4*)(ZM + row * 136 + ch * 8) = sm; }
    if (np == 0 && tid_ < 128) { const bf16* zr = (const bf16*)(F.ws + WS_PROJ) + (size_t)(b * SEQ + SEQ / 2) * INW + F_OFF + g_ * GD; float acc = 0.f;
        for (int c = 0; c < 128; ++c) acc += bf1(zr[c]) * bf1(MS[tid_ * 136 + c]);
        SPC[tid_] = acc; }
}
__device__ __forceinline__ void cd_compute(Frame& F, int it) {
    const int b = it >> 6, g_ = (it >> 4) & 3, np = it & 15, t0 = 128 * np;
    int lane_ = F.lane; asm volatile("" : "+v"(lane_));
    LAS bf16* MS = (LAS bf16*)(F.lds + DFTM_LDS); LAS bf16* ZP = (LAS bf16*)(F.lds + ZP_LDS); LAS bf16* ZM = (LAS bf16*)(F.lds + ZM_LDS); LAS float* SPC = (LAS float*)(F.lds + SPC_LDS);
    const int lane = lane_, w = F.wave, g = lane >> 4, n = lane & 15;
    bf16* Z = (bf16*)(F.ws + WS_ZCT);
#pragma unroll
    for (int half = 0; half < 2; ++half) {
        const LAS bf16* ZT = half ? ZM : ZP;
        bf16x8 zf[4];
#pragma unroll
        for (int ks = 0; ks < 4; ++ks) zf[ks] = *(const LAS bf16x8*)(ZT + (16 * w + n) * 136 + 32 * ks + 8 * g);
        f32x4 acc[8];
#pragma unroll
        for (int ct = 0; ct < 8; ++ct) { acc[ct] = (f32x4){0.f, 0.f, 0.f, 0.f};
#pragma unroll
            for (int ks = 0; ks < 4; ++ks) { const bf16x8 mf = *(const LAS bf16x8*)(MS + (128 * half + 16 * ct + n) * 136 + 32 * ks + 8 * g); acc[ct] = MFMA16(zf[ks], mf, acc[ct]); } }
#pragma unroll
        for (int ct = 0; ct < 8; ++ct) { const int cp = g_ * GD + 16 * ct + n;
            if (half == 1 && np == 0 && w == 0 && g == 0) acc[ct][0] = SPC[16 * ct + n];
            bf16* dst = Z + (size_t)(b * 512 + cp) * 4096 + half * 2048 + t0 + 16 * w + 4 * g;
            u32x2 o; o.x = pk2(acc[ct][0], acc[ct][1]); o.y = pk2(acc[ct][2], acc[ct][3]); *(u32x2*)dst = o; }
    }
}
__device__ __forceinline__ void cd_pipeline(Frame& F) {
    CdRegs R; int it = (F.c + 128) % F.G; if (it < 512) cd_load(F, it, R);
    while (it < 512) {
        __syncthreads(); cd_stage(F, it, R); __syncthreads();
        const int nit = it + F.G; if (nit < 512) cd_load(F, nit, R);
        cd_compute(F, it); it = nit;
    }
}

struct Args { const float* in[16]; float* out; unsigned char* ws; int ph_lo, ph_hi; };
__global__ void __launch_bounds__(NTHR, 2) fwd_kernel(Args args) {
    extern __shared__ __attribute__((aligned(16))) unsigned char lds_raw[];
    Frame F;
    F.lds = (LAS unsigned char*)lds_raw;
    F.tid = threadIdx.x; F.lane = F.tid & 63; { int w_ = __builtin_amdgcn_readfirstlane(F.tid >> 6); asm volatile("" : "+s"(w_)); F.wave = w_; }
    F.G = gridDim.x; F.c = blockIdx.x; F.ws = args.ws; F.out = args.out;
    volatile LAS unsigned* MISC = (volatile LAS unsigned*)(F.lds + MISC_OFF);
    for (int u = F.tid; u < (LDS_BYTES - MISC_OFF) / 4; u += NTHR) MISC[u] = 0u;
    __syncthreads();
    unsigned* ctl = (unsigned*)(F.ws + WS_CTL);
    (void)xcd_barrier_post(ctl + CW_BAR, MISC + 8);
#if MK_PER_PHASE_LAUNCH
    const int lo = args.ph_lo, hi = args.ph_hi;
    int ph = 0;
#endif
#if MK_PER_PHASE_LAUNCH
#define PH_ON (ph >= lo && ph < hi)
#define PH_END do { if (ph >= lo && ph + 1 < hi) { XcdBarrier b_; b_.x = xb_xcc_id(); b_.st = (volatile LAS unsigned*)(F.lds + MISC_OFF) + 8; b_.bar = (unsigned*)(F.ws + WS_CTL) + CW_BAR; xcd_barrier(b_, F.wave == 0 && (int)__builtin_amdgcn_mbcnt_hi(~0u, __builtin_amdgcn_mbcnt_lo(~0u, 0u)) == 0); } ++ph; } while (0)
#define PH_END_LAST PH_END
#else
#define PH_ON true
#define PH_END do { XcdBarrier b_; b_.x = xb_xcc_id(); b_.st = (volatile LAS unsigned*)(F.lds + MISC_OFF) + 8; b_.bar = (unsigned*)(F.ws + WS_CTL) + CW_BAR; xcd_barrier(b_, F.wave == 0 && (int)__builtin_amdgcn_mbcnt_hi(~0u, __builtin_amdgcn_mbcnt_lo(~0u, 0u)) == 0); } while (0)
#define PH_END_LAST do { } while (0)
#endif
#define PH_TID do { unsigned m_ = ~0u; asm volatile("" : "+s"(m_)); int l_ = (int)__builtin_amdgcn_mbcnt_hi(m_, __builtin_amdgcn_mbcnt_lo(m_, 0u)); F.lane = l_; F.tid = F.wave * 64 + l_; { int c_ = blockIdx.x, g_ = gridDim.x; asm volatile("" : "+s"(c_), "+s"(g_)); F.c = c_; F.G = g_; } const __attribute__((address_space(4))) Args* ap_ = (const __attribute__((address_space(4))) Args*)__builtin_amdgcn_kernarg_segment_ptr(); asm volatile("" : "+s"(ap_)); F.ws = ap_->ws; F.out = ap_->out; _Pragma("unroll") for (int i_ = 0; i_ < 16; ++i_) F.in[i_] = ap_->in[i_]; } while (0)
#define REPS(k) for (int rep_ = 0; rep_ < 1 + ((PROBE_REP >> (k)) & 1); ++rep_)
#define REP_SYNC(k) do { if (rep_ == 1) { XcdBarrier b_; b_.x = xb_xcc_id(); b_.st = (volatile LAS unsigned*)(F.lds + MISC_OFF) + 8; b_.bar = (unsigned*)(F.ws + WS_CTL) + CW_BAR; xcd_barrier(b_, F.wave == 0 && (int)__builtin_amdgcn_mbcnt_hi(~0u, __builtin_amdgcn_mbcnt_lo(~0u, 0u)) == 0); } } while (0)
    LAS unsigned char* ring = F.lds;
#define WIN ((bf16*)(F.ws + WS_WIN))
#define WBR ((bf16*)(F.ws + WS_WBR))
#define WOUT ((bf16*)(F.ws + WS_WOUT))
#define W1 ((bf16*)(F.ws + WS_W1))
#define W2 ((bf16*)(F.ws + WS_W2))
#define BUFA ((bf16*)(F.ws + WS_BUFA))
#define BUFB ((bf16*)(F.ws + WS_BUFB))
#define PROJ ((bf16*)(F.ws + WS_PROJ))
#define XC ((float*)(F.ws + WS_XC))
#define normg (F.in[6])

    if (PH_ON) REPS(0) { REP_SYNC(0); PH_TID; p0_body(F); }
    PH_END;
    if (PH_ON) REPS(0) { REP_SYNC(0); PH_TID; p0b_body(F); }
    PH_END;
    if (PH_ON) REPS(0) { REP_SYNC(0); PH_TID; RowPass P{}; P.xl_in = F.in[0]; P.xc_in = F.in[2]; P.xl_out = nullptr; P.xc_out = nullptr; P.Y = nullptr; P.gy = nullptr; P.gate_off = 0;
        P.gx = normg + 0 * DM; P.shift_off = 0; P.scale_off = DM; P.lnext = 0; P.l = 0; P.do_ctx = true; P.HX = BUFA; P.HX8 = F.ws + WS_HX8; row_pass(F, P); }
    PH_END;

    for (int l = 0; l < DEPTH; ++l) {
        const bool last = (l == DEPTH - 1);
        if (PH_ON) REPS(1) { REP_SYNC(1); PH_TID;
            {
                pg8::Gemm g{DM, DM, DM}; TileSched<GATE_OFF / 256> S; S.init(last ? 2 : 0, last ? 4 : GATE_OFF / 256, F.G, F.c, BUFA, (size_t)256 * DM * 2, WIN, (size_t)256 * DM * 2, DM / 64);
                EpiProj E{PROJ, (const float*)(F.ws + WS_TAB), 1.f};
                pg8::gemm_phase<EpiProj, TileSched<GATE_OFF / 256>, true, true, false, false, true>(ring, g, S, E, F.wave); }
            {
                pg8::Gemm g{DM / 2, DM / 2, DM / 2}; TileSched<(INW - GATE_OFF) / 256> S; S.init(0, last ? 0 : (INW - GATE_OFF) / 256, F.G, F.c, F.ws + WS_HX8, (size_t)256 * DM, F.ws + WS_WIN + (size_t)GATE_OFF * DM * 2, (size_t)256 * DM, DM / 128, 1, GATE_OFF);
                EpiProj E{PROJ, (const float*)(F.ws + WS_TAB), 0.015625f};
                pg8::gemm_phase<EpiProj, TileSched<(INW - GATE_OFF) / 256>, true, true, false, true, true>(ring, g, S, E, F.wave); }
            if (l == 0 && F.G == 256 && F.c >= 160) convert_weights(F, 0, CV_WIN, CV_WIN + 4 * CV_BR1 + CV_WO, 160, 96); }
        PH_END;
        if (PH_ON) REPS(2) { REP_SYNC(2); PH_TID;
            const int nmix = last ? 1024 : 1088;
            (void)nmix;
            ds_pipeline(F, l);
            sgu_pipeline(F, l, last);
            chdft_stage_m(F);
            cd_pipeline(F);
            if (!last) for (int it = (F.c + 192) % F.G; it < 64; it += F.G) chdft_ctx_item(F, it);
            conv_body(F, l, last ? RL : RT);
            __syncthreads();
        }
        PH_END;
        if (PH_ON) REPS(3) { REP_SYNC(3); PH_TID;
            scan_body(F, l);
            if (!last) { pg8::Gemm g{512, 512, 512}; DftSchedC S{F.G, F.c, (const char*)(F.ws + WS_DFTC), (const char*)(F.ws + WS_ZCT + 64 * MiB)};
                EpiPlain E{BUFB, DM, 0.005524271728019903f, nullptr};
                pg8::gemm_phase<EpiPlain, DftSchedC, false, true>(ring, g, S, E, F.wave); }
            { pg8::Gemm g{4096, 4096, 4096}; DftSchedL S{F.G, F.c, (const char*)(F.ws + WS_DFTL), (const char*)(F.ws + WS_ZCT)};
                EpiPlain E{BUFB, DM, 0.001381067932004976f, nullptr};
                pg8::gemm_phase<EpiPlain, DftSchedL, false, true>(ring, g, S, E, F.wave); }
        }
        PH_END;
        if (PH_ON) REPS(4) { REP_SYNC(4); PH_TID; const int nmix = last ? 1024 : 1088; for (int it = (F.c + 192) % F.G; it < nmix; it += F.G) ret_item_mfma(F, l, it, last); __syncthreads(); }
        PH_END;
        if (PH_ON) REPS(5) { REP_SYNC(5); PH_TID; pg8::Gemm g{DM, MIXW, MIXW}; const int nM = last ? 128 : 136; YSched S{nM, nM * 8, F.G, F.c, (const char*)BUFB, (const char*)WBR};
            EpiMerge E{PROJ, BUFA};
            pg8::gemm_phase<EpiMerge, YSched, true, true, false, false, true>(ring, g, S, E, F.wave);
            if (!last && F.G == 256 && F.c >= 64) convert_weights(F, l + 1, 0, CV_WIN, 64, 192);
            if (l == 0 && F.G == 256 && F.c >= 64) convert_weights(F, 0, CV_WIN + 4 * CV_BR1 + CV_WO, CV_WIN + 4 * CV_BR1 + CV_WO + CV_W1, 64, 192); }
        PH_END;
        if (PH_ON) REPS(6) { REP_SYNC(6); PH_TID; pg8::Gemm g{DM, DM, DM}; TileSched<8> S; S.init(0, last ? 0 : 8, F.G, F.c, BUFA, (size_t)256 * DM * 2, WOUT, (size_t)256 * DM * 2, DM / 64, 4, 0, 2048, 2048);
            EpiPlainFL E{BUFB, DM, 1.f, (float*)(F.ws + WS_ZCT)};
            pg8::gemm_phase<EpiPlainFL, TileSched<8>, true, true, false, false, true, true>(ring, g, S, E, F.wave); }
        PH_END;
        if (PH_ON) { PH_TID; RowPass P{}; P.xl_in = (l == 0) ? F.in[0] : (const float*)F.out; P.xc_in = (l == 0) ? F.in[2] : (const float*)XC; P.xl_out = nullptr; P.xc_out = XC; P.Y = BUFB;
            P.gy = normg + (size_t)(l * 4 + 1) * DM; P.gate_off = 2 * DM; P.gx = normg + (size_t)(l * 4 + 2) * DM; P.shift_off = 3 * DM; P.scale_off = 4 * DM; P.lnext = l; P.l = l; P.do_ctx = !last; P.HX = BUFA; P.part = (const float*)(F.ws + WS_ZCT);
            row_pass(F, P); }
        PH_END;
        if (PH_ON) REPS(8) { REP_SYNC(8); PH_TID; pg8::Gemm g{DM, DM, DM}; TileSched<2 * DFF / 256> S; S.init(0, last ? 0 : 2 * DFF / 256, F.G, F.c, BUFA, (size_t)256 * DM * 2, W1, (size_t)256 * DM * 2, DM / 64);
            EpiSwiglu E{PROJ};
            pg8::gemm_phase<EpiSwiglu, TileSched<2 * DFF / 256>, true, true, false, false, true>(ring, g, S, E, F.wave);
            if (l == 0 && F.G == 256 && F.c >= 96) convert_weights(F, 0, CV_WIN + 4 * CV_BR1 + CV_WO + CV_W1, CV_TOTAL, 96, 160);
            if (!last && F.G == 256 && F.c >= 96) convert_weights(F, l + 1, CV_WIN, CV_WIN + 4 * CV_BR1 + CV_WO, 96, 160); }
        PH_END;
        if (PH_ON) REPS(9) { REP_SYNC(9); PH_TID; pg8::Gemm g{DFF, DFF, DFF}; TileSched<8> S; S.init(0, last ? 0 : 8, F.G, F.c, PROJ, (size_t)256 * DFF * 2, W2, (size_t)256 * DFF * 2, DFF / 64, 4, 0, 2048, 2048);
            EpiPlainFL E{BUFA, DM, 1.f, (float*)(F.ws + WS_ZCT)};
            pg8::gemm_phase<EpiPlainFL, TileSched<8>, true, true, false, false, true, true>(ring, g, S, E, F.wave); }
        PH_END;
        if (PH_ON) { PH_TID; RowPass P{}; P.xl_in = (l == 0) ? F.in[0] : (const float*)F.out; P.xc_in = XC; P.xl_out = F.out; P.xc_out = XC; P.Y = BUFA;
            P.Y0 = BUFB; P.gy0 = normg + (size_t)(l * 4 + 1) * DM; P.gate0_off = 2 * DM;
            P.gy = normg + (size_t)(l * 4 + 3) * DM; P.gate_off = 5 * DM; P.gx = last ? nullptr : normg + (size_t)((l + 1) * 4 + 0) * DM; P.shift_off = 0; P.scale_off = DM; P.lnext = last ? -1 : l + 1; P.l = l; P.do_ctx = !last; P.HX = BUFA; P.HX8 = F.ws + WS_HX8; P.part = (const float*)(F.ws + WS_ZCT);
            row_pass(F, P);
            if (!last) convert_weights(F, l + 1, F.G == 256 ? CV_WIN + 4 * CV_BR1 + CV_WO : 0, CV_TOTAL, 0, F.G); }
        if (!last) PH_END; else PH_END_LAST;
    }
#undef PH_ON
#undef PH_END
#undef PH_END_LAST
#undef WIN
#undef WBR
#undef WOUT
#undef W1
#undef W2
#undef BUFA
#undef BUFB
#undef PROJ
#undef XC
#undef normg
}

constexpr int N_PHASES = 3 + DEPTH * 10;
extern "C" void kernel_launch(void* const* d_in, const int* in_sizes, int n_in, void* d_out, int out_size, void* d_ws, size_t ws_size, hipStream_t stream) {
    static int grid = 0;
    if (grid == 0) {
        if (n_in != 16 || out_size != RL * DM || ws_size < WS_END) { fprintf(stderr, "kernel_launch: unexpected shapes (n_in %d, out %d, ws %zu < %zu); nothing launched\n", n_in, out_size, ws_size, (size_t)WS_END); grid = -1; return; }
        int dev = 0, cus = 0, per_cu = 0;
        if (hipGetDevice(&dev) != hipSuccess || hipDeviceGetAttribute(&cus, hipDeviceAttributeMultiprocessorCount, dev) != hipSuccess) { grid = -1; return; }
        if (hipFuncSetAttribute((const void*)fwd_kernel, hipFuncAttributeMaxDynamicSharedMemorySize, LDS_BYTES) != hipSuccess) { fprintf(stderr, "kernel_launch: hipFuncSetAttribute failed\n"); grid = -1; return; }
        if (hipOccupancyMaxActiveBlocksPerMultiprocessor(&per_cu, (const void*)fwd_kernel, NTHR, LDS_BYTES) != hipSuccess || per_cu < 1)
            fprintf(stderr, "kernel_launch: occupancy query reports %d workgroups per CU\n", per_cu);
        (void)hipGetLastError();
        grid = cus;
    }
    if (grid < 0) return;
    (void)in_sizes;
    if (hipMemsetAsync((char*)d_ws + WS_CTL, 0, CTL_ZERO_BYTES, stream) != hipSuccess) return;
    Args a{};
    for (int i = 0; i < 16; ++i) a.in[i] = (const float*)d_in[i];
    a.out = (float*)d_out; a.ws = (unsigned char*)d_ws;
#if MK_PER_PHASE_LAUNCH
    for (int p = 0; p < N_PHASES; ++p) { a.ph_lo = p; a.ph_hi = p + 1; hipLaunchKernelGGL(fwd_kernel, dim3(grid), dim3(NTHR), LDS_BYTES, stream, a); }
#else
    a.ph_lo = 0; a.ph_hi = N_PHASES;
    hipLaunchKernelGGL(fwd_kernel, dim3(grid), dim3(NTHR), LDS_BYTES, stream, a);
#endif
    const hipError_t le = hipPeekAtLastError();
    if (le != hipSuccess) fprintf(stderr, "kernel_launch: launch failed: %s\n", hipGetErrorName(le));
}
```

```cpp
#include <hip/hip_runtime.h>
#include <cstdio>
#include <cstdint>

#ifndef PROBE_REP
#define PROBE_REP 0
#endif
#ifndef MK_PER_PHASE_LAUNCH
#define MK_PER_PHASE_LAUNCH 0
#endif

namespace pg8 {
#define PG8_LAS __attribute__((address_space(3)))
typedef unsigned short bf16_t;
typedef short bf16x8 __attribute__((ext_vector_type(8)));
typedef float f32x4 __attribute__((ext_vector_type(4)));
typedef unsigned u32x4 __attribute__((ext_vector_type(4)));
typedef int i32x4 __attribute__((ext_vector_type(4)));
constexpr int BM = 256, BK = 64, HALF = 128, HTB = HALF * BK * 2, STAGE_BYTES = 8 * HTB, NXCD = 8, WGM = 8;

__host__ __device__ __forceinline__ int lds_byte(int r, int c) { const int st = (r >> 4) * 2 + (c >> 5), rr = r & 15, cc = c & 31, ob = rr * 64 + cc * 2; return st * 1024 + (ob ^ (((ob >> 9) & 1) << 5)); }
__host__ __device__ __forceinline__ void stage_rc(int b, int& R, int& C) { const int st = b / 1024, sb = b % 1024, swz = sb ^ (((sb >> 9) & 1) << 5); R = (st >> 1) * 16 + swz / 64; C = (st & 1) * 32 + (swz % 64) / 2; }
__host__ __device__ __forceinline__ int perm32(int rho) { const int n = rho >> 4, i = rho & 15; return 8 * (i >> 2) + 4 * n + (i & 3); }

struct Unit { int row0, col0, z, nt; const char* a; const char* b; };
struct Gemm { int lda, ldb, K; };

template <int nM, int nN> __device__ __forceinline__ void map_tile(int wgid, int& pm, int& pn) {
    constexpr int nwg = nM * nN;
    { constexpr int q = nwg / NXCD, r = nwg % NXCD; const int xcd = wgid % NXCD, off = wgid / NXCD; wgid = (xcd < r ? xcd * (q + 1) : r * (q + 1) + (xcd - r) * q) + off; }
    constexpr int nig = WGM * nN; const int gid = wgid / nig, fm = gid * WGM, gsz = (nM - fm) < WGM ? (nM - fm) : WGM;
    pm = fm + ((wgid % nig) % gsz); pn = (wgid % nig) / gsz;
}

typedef float cvt_f32x2 __attribute__((ext_vector_type(2)));
typedef __bf16 cvt_bf16x2 __attribute__((ext_vector_type(2)));
__device__ __forceinline__ unsigned cvt_pk_bf16(float lo, float hi) { const cvt_f32x2 v = {lo, hi}; const cvt_bf16x2 b = __builtin_convertvector(v, cvt_bf16x2); return __builtin_bit_cast(unsigned, b); }

template <class Epi, class Sched, bool ALIGN_EPI = false, bool SP2 = false, bool RELAX = false, bool FP8 = false, bool BLKB = false, bool BLKA = false>
__device__ __forceinline__ void gemm_phase(PG8_LAS unsigned char* lds, const Gemm g, const Sched& S, const Epi& E, const int wave_id) {
    unsigned m_ = ~0u; asm volatile("" : "+s"(m_)); int lane_ = (int)__builtin_amdgcn_mbcnt_hi(m_, __builtin_amdgcn_mbcnt_lo(m_, 0u));
    const int wid = wave_id, lane = lane_, tid = wid * 64 + lane, wr = wid >> 2, wc = wid & 3, fr = lane & 15, fq = lane >> 4;
    unsigned voffA[2], voffB[2];
#pragma unroll
    for (int i = 0; i < 2; ++i) { int R, C; stage_rc(tid * 16 + i * 8192, R, C); const int Rb = (R & ~31) + perm32(R & 31);
        voffA[i] = BLKA ? (unsigned)(((R >> 4) * ((g.lda * 2) >> 6) + ((C * 2) >> 6)) * 1024 + (R & 15) * 64 + ((C * 2) & 63)) : (unsigned)(R * g.lda + C) * 2u;
        voffB[i] = BLKB ? (unsigned)(((R >> 4) * ((g.ldb * 2) >> 6) + ((C * 2) >> 6)) * 1024 + (R & 15) * 64 + ((C * 2) & 63)) : (unsigned)(Rb * g.ldb + C) * 2u; }
    const size_t kstep = BLKA ? (size_t)2048 : (size_t)(BK * 2), kstepB = BLKB ? (size_t)2048 : (size_t)(BK * 2);
    const size_t hstepA = (size_t)HALF * g.lda * 2, hstepB = (size_t)HALF * g.ldb * 2;
    const unsigned ldsw = (unsigned)wid * 1024u;
    const int aoff = lds_byte(wr * 64 + fr, fq * 8), boff = lds_byte(wc * 32 + fr, fq * 8);
#define PG8_SA(b, h) (((b) * 2 + (h)) * HTB)
#define PG8_SB(b, h) ((4 + (b) * 2 + (h)) * HTB)
#define PG8_STAGE(bufoff, gbase, voff) do { _Pragma("unroll") for (int _i = 0; _i < 2; ++_i) \
        __builtin_amdgcn_global_load_lds((const unsigned*)((const char*)(gbase) + (voff)[_i]), (PG8_LAS unsigned*)(lds + (bufoff) + ldsw + _i * 8192), 16, 0, 0); } while (0)
#define PG8_LDA(dst, b, h) do { _Pragma("unroll") for (int m = 0; m < 4; ++m) _Pragma("unroll") for (int k = 0; k < 2; ++k) dst[m][k] = *(const PG8_LAS bf16x8*)(lds + PG8_SA(b, h) + aoff + m * 2048 + k * 1024); } while (0)
#define PG8_LDB(dst, b, h) do { _Pragma("unroll") for (int n = 0; n < 2; ++n) _Pragma("unroll") for (int k = 0; k < 2; ++k) dst[n][k] = *(const PG8_LAS bf16x8*)(lds + PG8_SB(b, h) + boff + n * 2048 + k * 1024); } while (0)
#define PG8_CAT8(x) __builtin_shufflevector(__builtin_bit_cast(i32x4, x[0]), __builtin_bit_cast(i32x4, x[1]), 0, 1, 2, 3, 4, 5, 6, 7)
#define PG8_MMA(ai, bj, At, Bt) do { __builtin_amdgcn_s_setprio(1); \
        if constexpr (FP8) { _Pragma("unroll") for (int m = 0; m < 4; ++m) _Pragma("unroll") for (int n = 0; n < 2; ++n) \
            asm volatile("v_mfma_f32_16x16x128_f8f6f4 %0, %1, %2, %0" : "+v"(acc[ai][bj][m][n]) : "v"(PG8_CAT8(Bt[n])), "v"(PG8_CAT8(At[m]))); } \
        else { _Pragma("unroll") for (int m = 0; m < 4; ++m) _Pragma("unroll") for (int n = 0; n < 2; ++n) _Pragma("unroll") for (int k = 0; k < 2; ++k) \
            acc[ai][bj][m][n] = __builtin_amdgcn_mfma_f32_16x16x32_bf16(Bt[n][k], At[m][k], acc[ai][bj][m][n], 0, 0, 0); } \
        __builtin_amdgcn_s_setprio(0); } while (0)
#define PG8_WAIT_V(n) asm volatile("s_waitcnt vmcnt(" #n ")" ::: "memory")
#define PG8_WAIT_L(n) asm volatile("s_waitcnt lgkmcnt(" #n ")" ::: "memory")
#define PG8_WAIT_VR() do { if constexpr (RELAX && Epi::NSTORE >= 16) asm volatile("s_cmp_eq_u32 %0, 0\n\ts_cbranch_scc1 1f\n\ts_waitcnt vmcnt(24)\n\ts_branch 2f\n1:\n\ts_waitcnt vmcnt(8)\n2:" :: "s"(rlx) : "scc", "memory"); \
        else if constexpr (RELAX && Epi::NSTORE >= 8) asm volatile("s_cmp_eq_u32 %0, 0\n\ts_cbranch_scc1 1f\n\ts_waitcnt vmcnt(16)\n\ts_branch 2f\n1:\n\ts_waitcnt vmcnt(8)\n2:" :: "s"(rlx) : "scc", "memory"); \
        else PG8_WAIT_V(8); } while (0)
#define PG8_BAR __builtin_amdgcn_s_barrier()
#define PG8_SCHED __builtin_amdgcn_sched_barrier(0)
    Unit cur, nxt; int ui = 0; int pre = 0;
    if (!S.next(0, cur)) return;
    f32x4 acc[2][2][4][2];
#pragma unroll
    for (int a = 0; a < 2; ++a)
#pragma unroll
        for (int b = 0; b < 2; ++b)
#pragma unroll
            for (int m = 0; m < 4; ++m)
#pragma unroll
                for (int n = 0; n < 2; ++n) acc[a][b][m][n] = (f32x4){0.f, 0.f, 0.f, 0.f};
    bf16x8 At[4][2], B0[2][2], B1[2][2];
    const char* cA = cur.a; const char* cB = cur.b;
    if constexpr (SP2) {
        PG8_STAGE(PG8_SB(0, 0), cB, voffB); PG8_STAGE(PG8_SB(0, 1), cB + hstepB, voffB); PG8_STAGE(PG8_SA(0, 0), cA, voffA); PG8_STAGE(PG8_SA(0, 1), cA + hstepA, voffA);
        if (wr == 1) PG8_BAR;
        PG8_WAIT_V(2); PG8_BAR;
        PG8_STAGE(PG8_SB(1, 0), cB + kstepB, voffB); PG8_STAGE(PG8_SA(1, 0), cA + kstep, voffA); PG8_STAGE(PG8_SB(1, 1), cB + hstepB + kstepB, voffB);
        PG8_WAIT_V(6); PG8_BAR;
    } else {
        PG8_STAGE(PG8_SB(0, 0), cB, voffB); PG8_STAGE(PG8_SA(0, 0), cA, voffA); PG8_STAGE(PG8_SB(0, 1), cB + hstepB, voffB); PG8_STAGE(PG8_SA(0, 1), cA + hstepA, voffA);
        if (wr == 1) PG8_BAR;
        PG8_WAIT_V(4); PG8_BAR;
        PG8_STAGE(PG8_SB(1, 0), cB + kstepB, voffB); PG8_STAGE(PG8_SA(1, 0), cA + kstep, voffA); PG8_STAGE(PG8_SB(1, 1), cB + hstepB + kstepB, voffB);
        PG8_WAIT_V(6); PG8_BAR;
    }
    for (;;) {
        const bool has_next = S.next(ui + 1, nxt);
        const char* nA = has_next ? nxt.a : cA; const char* nB = has_next ? nxt.b : cB;
        const int nt = cur.nt;
        for (int t = 0; t < nt; t += 2) {
            const bool last = (t == nt - 2);
            const char* a1 = cA + (size_t)(t + 1) * kstep;
            const char* a2 = last ? nA : cA + (size_t)(t + 2) * kstep; const char* b2 = last ? nB : cB + (size_t)(t + 2) * kstepB;
            const char* a3 = a2 + kstep; const char* b3 = b2 + kstepB;
            if constexpr (SP2) {
            const int rlx = (t == 0) ? pre : 0;
            PG8_LDB(B0, 0, 0); PG8_LDB(B1, 0, 1); PG8_SCHED; PG8_LDA(At, 0, 0); PG8_STAGE(PG8_SA(1, 1), a1 + hstepA, voffA);
            PG8_WAIT_VR(); PG8_WAIT_L(0); PG8_BAR; PG8_MMA(0, 0, At, B0); PG8_MMA(0, 1, At, B1); PG8_BAR; PG8_SCHED;
            PG8_LDA(At, 0, 1); PG8_STAGE(PG8_SB(0, 0), b2, voffB); PG8_STAGE(PG8_SB(0, 1), b2 + hstepB, voffB); PG8_STAGE(PG8_SA(0, 0), a2, voffA);
            PG8_WAIT_VR(); PG8_WAIT_L(0); PG8_BAR; PG8_MMA(1, 0, At, B0); PG8_MMA(1, 1, At, B1); PG8_BAR; PG8_SCHED;
            PG8_LDB(B0, 1, 0); PG8_LDB(B1, 1, 1); PG8_SCHED; PG8_LDA(At, 1, 0); PG8_STAGE(PG8_SA(0, 1), a2 + hstepA, voffA);
            PG8_WAIT_V(8); PG8_WAIT_L(0); PG8_BAR; PG8_MMA(0, 0, At, B0); PG8_MMA(0, 1, At, B1); PG8_BAR; PG8_SCHED;
            PG8_LDA(At, 1, 1); PG8_STAGE(PG8_SB(1, 0), b3, voffB); PG8_STAGE(PG8_SB(1, 1), b3 + hstepB, voffB); PG8_STAGE(PG8_SA(1, 0), a3, voffA);
            PG8_WAIT_V(8); PG8_WAIT_L(0); PG8_BAR; PG8_MMA(1, 0, At, B0); PG8_MMA(1, 1, At, B1); PG8_BAR; PG8_SCHED;
            } else {
            PG8_LDB(B0, 0, 0); PG8_SCHED; PG8_LDA(At, 0, 0); PG8_STAGE(PG8_SA(1, 1), a1 + hstepA, voffA);
            PG8_WAIT_L(8); PG8_BAR; PG8_WAIT_L(0); PG8_MMA(0, 0, At, B0); PG8_BAR; PG8_SCHED;
            PG8_LDB(B1, 0, 1); PG8_STAGE(PG8_SB(0, 0), b2, voffB);
            PG8_BAR; PG8_WAIT_L(0); PG8_MMA(0, 1, At, B1); PG8_BAR;
            PG8_LDA(At, 0, 1); PG8_STAGE(PG8_SA(0, 0), a2, voffA);
            PG8_BAR; PG8_WAIT_L(0); PG8_MMA(1, 0, At, B0); PG8_BAR; PG8_SCHED;
            PG8_STAGE(PG8_SB(0, 1), b2 + hstepB, voffB);
            PG8_WAIT_V(6); PG8_BAR; PG8_MMA(1, 1, At, B1); PG8_BAR;
            PG8_LDB(B0, 1, 0); PG8_SCHED; PG8_LDA(At, 1, 0); PG8_STAGE(PG8_SA(0, 1), a2 + hstepA, voffA);
            PG8_WAIT_L(8); PG8_BAR; PG8_WAIT_L(0); PG8_MMA(0, 0, At, B0); PG8_BAR; PG8_SCHED;
            PG8_LDB(B1, 1, 1); PG8_STAGE(PG8_SB(1, 0), b3, voffB);
            PG8_BAR; PG8_WAIT_L(0); PG8_MMA(0, 1, At, B1); PG8_BAR;
            PG8_LDA(At, 1, 1); PG8_STAGE(PG8_SA(1, 0), a3, voffA);
            PG8_BAR; PG8_WAIT_L(0); PG8_MMA(1, 0, At, B0); PG8_BAR; PG8_SCHED;
            PG8_STAGE(PG8_SB(1, 1), b3 + hstepB, voffB);
            PG8_WAIT_V(6); PG8_BAR; PG8_MMA(1, 1, At, B1); PG8_BAR;
            }
        }
        if constexpr (ALIGN_EPI) { if (wr == 0) PG8_BAR; }
        if constexpr (RELAX && SP2 && Epi::NSTORE >= 8) pre = 1;
        if constexpr (Epi::CHAIN) {
            const bool keep = E.chain(acc, cur, wr, wc);
            if (!has_next) break;
            if (!keep) {
#pragma unroll
                for (int a = 0; a < 2; ++a)
#pragma unroll
                    for (int b = 0; b < 2; ++b)
#pragma unroll
                        for (int m = 0; m < 4; ++m)
#pragma unroll
                            for (int n = 0; n < 2; ++n) acc[a][b][m][n] = (f32x4){0.f, 0.f, 0.f, 0.f};
            }
        } else {
        E(acc, cur, wr, wc);
        if (!has_next) break;
#pragma unroll
        for (int a = 0; a < 2; ++a)
#pragma unroll
            for (int b = 0; b < 2; ++b)
#pragma unroll
                for (int m = 0; m < 4; ++m)
#pragma unroll
                    for (int n = 0; n < 2; ++n) acc[a][b][m][n] = (f32x4){0.f, 0.f, 0.f, 0.f};
        }
        cur = nxt; cA = nA; cB = nB; ++ui;
        if constexpr (ALIGN_EPI) { if (wr == 1) PG8_BAR; }
    }
    PG8_WAIT_V(0);
    if constexpr (!ALIGN_EPI) { if (wr == 0) PG8_BAR; }
    PG8_BAR;
#undef PG8_SA
#undef PG8_SB
#undef PG8_STAGE
#undef PG8_LDA
#undef PG8_LDB
#undef PG8_MMA
#undef PG8_CAT8
#undef PG8_WAIT_V
#undef PG8_WAIT_L
#undef PG8_WAIT_VR
#undef PG8_BAR
#undef PG8_SCHED
}
}

constexpr int DM = 2048, NB = 8, SEQ = 4096, CTXL = 256, DEPTH = 4, MIXW = 512, GD = 128, NGRP = 4;
constexpr int INW = 13312, DFF = 5632, ADAW = 6 * DM, NCOND = NB + 1;
constexpr int RL = NB * SEQ, RC = NB * CTXL, RT = RL + RC;
constexpr int Q_OFF = 0, K_OFF = 512, V_OFF = 1024, G_OFF = 1536, F_OFF = 2048, U_OFF = 2560, VS_OFF = 3072, SCB_OFF = 3584, SCC_OFF = 4096, SCX_OFF = 4608, GATE_OFF = 5120;
constexpr int NCH = 34;
constexpr float EPS = 1e-6f;
constexpr int NWAVES = 8, NTHR = 512;

constexpr size_t MiB = 1u << 20;
constexpr size_t WS_CTL = 0, CTL_ZERO_BYTES = 1 * MiB;
constexpr size_t WS_MOD = 1 * MiB;
constexpr size_t WS_MODP = 3 * MiB;
constexpr size_t WS_TAB = 17 * MiB;
constexpr size_t WS_DFTC = 18 * MiB;
constexpr size_t WS_DFTL = 19 * MiB;
constexpr size_t WS_XC = 83 * MiB;
constexpr size_t WS_WIN = 99 * MiB;
constexpr size_t WS_WBR = 151 * MiB;
constexpr size_t WS_WOUT = 159 * MiB;
constexpr size_t WS_W1 = 167 * MiB;
constexpr size_t WS_W2 = 211 * MiB;
constexpr size_t WS_BUFA = 233 * MiB;
constexpr size_t WS_BUFB = 369 * MiB;
constexpr size_t WS_ZCT = 505 * MiB;
constexpr size_t WS_ST = 573 * MiB;
constexpr size_t WS_PROJ = 641 * MiB;
constexpr size_t WS_HX8 = 1525 * MiB;
constexpr size_t WS_END = 1593 * MiB;
static_assert(WS_PROJ + (size_t)RT * INW * 2 <= WS_END, "ws map");
static_assert((size_t)NB * NGRP * 2 * NCH * GD * GD * 4 <= WS_BUFB - WS_BUFA, "DS overlay fits BUFA");
static_assert((size_t)NB * NGRP * 2 * NCH * GD * GD * 2 <= WS_PROJ - WS_ST, "states");

constexpr int CW_TMO = 0;
constexpr int CW_BAR = 4096;

constexpr int SCR_BYTES = 155648;
constexpr int MISC_OFF = SCR_BYTES;
constexpr int LDS_BYTES = SCR_BYTES + 1024;

#define GAS __attribute__((address_space(1)))
#define LAS __attribute__((address_space(3)))
typedef unsigned short bf16;
typedef float f32x4 __attribute__((ext_vector_type(4)));
typedef float f32x2 __attribute__((ext_vector_type(2)));
typedef unsigned u32x4 __attribute__((ext_vector_type(4)));
typedef unsigned u32x2 __attribute__((ext_vector_type(2)));

__device__ __forceinline__ unsigned f2bf(float f) { unsigned u = __builtin_bit_cast(unsigned, f); return (u + 0x7fffu + ((u >> 16) & 1u)) >> 16; }
__device__ __forceinline__ unsigned pk2(float lo, float hi) { return pg8::cvt_pk_bf16(lo, hi); }
__device__ __forceinline__ float bflo(unsigned w) { return __builtin_bit_cast(float, w << 16); }
__device__ __forceinline__ float bfhi(unsigned w) { return __builtin_bit_cast(float, w & 0xffff0000u); }
__device__ __forceinline__ float bf1(unsigned short h) { return __builtin_bit_cast(float, (unsigned)h << 16); }
__device__ __forceinline__ float sigmoid_f(float x) { return __builtin_amdgcn_rcpf(1.f + __expf(-x)); }
__device__ __forceinline__ float silu_f(float x) { return x * sigmoid_f(x); }
__device__ __forceinline__ float gelu_tanh_f(float x) { const float u = 0.7978845608028654f * (x + 0.044715f * x * x * x); return x * sigmoid_f(2.f * u); }

#define XB_TMO      128
#define XB_XCNT(j)  (256  + 64 * (j))
#define XB_XSUB(j)  (1280 + 64 * (j))
#define XB_XGEN(j)  (2304 + 64 * (j))
#define XB_TOP      3328
#define XB_TOPGEN   3392
#define XCD_BAR_WORDS 3456
#define XB_SPIN_CAP (1u << 18)
__device__ __forceinline__ unsigned xb_ld(unsigned* p)              { return __hip_atomic_load(p, __ATOMIC_RELAXED, __HIP_MEMORY_SCOPE_AGENT); }
__device__ __forceinline__ unsigned xb_add(unsigned* p, unsigned v) { return __hip_atomic_fetch_add(p, v, __ATOMIC_RELAXED, __HIP_MEMORY_SCOPE_AGENT); }
__device__ __forceinline__ unsigned xb_xcc_id() { return (unsigned)__builtin_amdgcn_s_getreg((3 << 11) | 20) & 0xFu; }
#define XB_SPIN(cond, bar) do { unsigned _sp = 0; while (cond) { __builtin_amdgcn_s_sleep(1); \
    if ((++_sp & 255u) == 0u) { if (xb_ld(&(bar)[XB_TMO])) break; if (_sp > XB_SPIN_CAP) { atomicAdd(&(bar)[XB_TMO], 1u); break; } } } } while (0)
struct XcdBarrier { unsigned* bar; unsigned x; volatile LAS unsigned* st; };
__device__ __forceinline__ XcdBarrier xcd_barrier_post(unsigned* bar, volatile LAS unsigned* st) {
    XcdBarrier b; b.bar = bar; b.x = xb_xcc_id(); b.st = st;
    if (threadIdx.x == 0) (void)xb_add(&bar[XB_XCNT(b.x)], 1u);
    return b;
}
__device__ __forceinline__ void xcd_barrier_complete(unsigned* bar, unsigned x, unsigned& nloc, unsigned& nx) {
    const unsigned G = gridDim.x * gridDim.y * gridDim.z;
    unsigned sum, cnt, mine, sp = 0u;
    for (;;) {
        sum = 0u; cnt = 0u; mine = 0u;
#pragma unroll
        for (unsigned j = 0; j < 16; ++j) { const unsigned c = xb_ld(&bar[XB_XCNT(j)]); sum += c; cnt += (c > 0u) ? 1u : 0u; mine = (j == x) ? c : mine; }
        if (sum == G) break;
        __builtin_amdgcn_s_sleep(1);
        if ((++sp & 255u) == 0u) { if (xb_ld(&bar[XB_TMO])) break; if (sp > XB_SPIN_CAP) { atomicAdd(&bar[XB_TMO], 1u); break; } }
    }
    nloc = mine > 0u ? mine : 1u; nx = cnt > 0u ? cnt : 1u;
}
__device__ __forceinline__ void xcd_barrier(const XcdBarrier& b, const bool leader  ) {
    asm volatile("s_waitcnt vmcnt(0)" ::: "memory");
    __syncthreads();
    if (leader) {
        unsigned* bar = b.bar;
        __builtin_amdgcn_s_waitcnt(0);
        unsigned nloc = b.st[0], nx = b.st[1];
        if (nloc == 0u) { xcd_barrier_complete(bar, b.x, nloc, nx); b.st[0] = nloc; b.st[1] = nx; }
        const unsigned old = xb_add(&bar[XB_XSUB(b.x)], 1u);
        const unsigned gen = old / nloc;
        if (old + 1u == (gen + 1u) * nloc) {
            __builtin_amdgcn_fence(__ATOMIC_RELEASE, "agent");
            asm volatile("s_waitcnt vmcnt(0)" ::: "memory");
            const unsigned og = xb_add(&bar[XB_TOP], 1u);
            const unsigned tg = og / nx;
            if (og + 1u == (tg + 1u) * nx) xb_add(&bar[XB_TOPGEN], 1u);
            else XB_SPIN(xb_ld(&bar[XB_TOPGEN]) == tg, bar);
            __builtin_amdgcn_fence(__ATOMIC_ACQUIRE, "agent");
            xb_add(&bar[XB_XGEN(b.x)], 1u);
            asm volatile("s_waitcnt vmcnt(0)" ::: "memory");
        } else {
            XB_SPIN(xb_ld(&bar[XB_XGEN(b.x)]) == gen, bar);
            __builtin_amdgcn_fence(__ATOMIC_ACQUIRE, "agent");
            asm volatile("s_waitcnt vmcnt(0)" ::: "memory");
        }
    }
    __syncthreads();
}

using pg8::Unit; using pg8::cvt_pk_bf16;
__device__ __forceinline__ u32x4 pack8(const f32x4 v0, const f32x4 v1) { u32x4 w; w.x = cvt_pk_bf16(v0[0], v0[1]); w.y = cvt_pk_bf16(v0[2], v0[3]); w.z = cvt_pk_bf16(v1[0], v1[1]); w.w = cvt_pk_bf16(v1[2], v1[3]); return w; }

struct EpiProj {
    static constexpr bool CHAIN = false; static constexpr int NSTORE = 16;
    bf16* O; const float* rope; float gsc;
    __device__ __forceinline__ void operator()(const f32x4 (&acc)[2][2][4][2], const Unit& u, int wr, int wc) const {
        unsigned em_ = ~0u; asm volatile("" : "+s"(em_)); const int el_ = (int)__builtin_amdgcn_mbcnt_hi(em_, __builtin_amdgcn_mbcnt_lo(em_, 0u)); const int fr = el_ & 15, fq = el_ >> 4;
        const int col0 = u.col0; const bool ctx = u.row0 >= RL;
        int act;
        if (col0 < K_OFF) act = ctx ? 0 : 4; else if (col0 < V_OFF) act = ctx ? 6 : 5; else if (col0 < G_OFF) act = 0; else if (col0 < F_OFF) act = 1;
        else if (col0 < U_OFF) act = 0; else if (col0 < SCB_OFF) act = 2; else if (col0 < GATE_OFF) act = 0; else act = 3;
        const float ksc = (act == 5 || act == 6) ? 0.08838834764831845f : 1.f;
        const int rowb = u.row0 + wr * 64 + fr, colb = col0 + wc * 32 + 8 * fq;
        if (act == 3) {
            const float nsc = -1.4426950408889634f * gsc;
            const int pg = (col0 - GATE_OFF) >> 8, pn_c = pg >> 2, bj_c = (pg >> 1) & 1, w_c = wr * 4 + ((pg & 1) << 1) + (wc >> 1), lane_c = fr + 16 * (2 * (wc & 1) + (fq & 1));
            const int slot0 = u.row0 + 32 * pn_c + w_c + ((fq >> 1) ? 8 : 0);
#pragma unroll
            for (int ai = 0; ai < 2; ++ai)
#pragma unroll
                for (int m = 0; m < 4; ++m) {
                    bf16* rowp = O + (size_t)slot0 * INW + GATE_OFF + (((ai * 4 + m) * 2 + bj_c) * 64 + lane_c) * 8;
                    unsigned ow[4][2];
#pragma unroll
                    for (int hp = 0; hp < 2; ++hp) {
                        float t[4][2], r[4][2];
#pragma unroll
                        for (int gn = 0; gn < 4; ++gn)
#pragma unroll
                            for (int e = 0; e < 2; ++e) { t[gn][e] = 1.f + __builtin_amdgcn_exp2f(fminf(acc[ai][gn >> 1][m][gn & 1][2 * hp + e] * nsc, 86.5617f)); r[gn][e] = __builtin_amdgcn_rcpf(t[gn][e]); }
#pragma unroll
                        for (int gn = 0; gn < 4; ++gn) ow[gn][hp] = (gn < 3) ? cvt_pk_bf16(t[gn + 1 > 3 ? 3 : gn + 1][0] * r[gn][0], t[gn + 1 > 3 ? 3 : gn + 1][1] * r[gn][1]) : cvt_pk_bf16(r[3][0], r[3][1]);
                    }
#pragma unroll
                    for (int pr = 0; pr < 4; pr += 2) {
                        const auto sx = __builtin_amdgcn_permlane32_swap(ow[pr][0], ow[pr + 1][0], false, false);
                        const auto sy = __builtin_amdgcn_permlane32_swap(ow[pr][1], ow[pr + 1][1], false, false);
                        u32x4 o; o.x = sx[0]; o.y = sy[0]; o.z = sx[1]; o.w = sy[1];
                        *(u32x4*)(rowp + (size_t)(8 * pr) * INW) = o; }
                    __builtin_amdgcn_sched_barrier(0);
                }
            return;
        }
        const bool hi = fr >= 8;
#pragma unroll
        for (int ai = 0; ai < 2; ++ai)
#pragma unroll
            for (int m = 0; m < 4; ++m) {
                const int rowg = u.row0 + wr * 64 + ai * 128 + m * 16, row = rowg + fr;
                u32x4 w[2];
#pragma unroll
                for (int bj = 0; bj < 2; ++bj) {
                    f32x4 v0 = acc[ai][bj][m][0], v1 = acc[ai][bj][m][1];
                    if (act == 1) {
#pragma unroll
                        for (int e = 0; e < 4; ++e) { v0[e] = silu_f(v0[e]); v1[e] = silu_f(v1[e]); }
                    } else if (act == 2) {
#pragma unroll
                        for (int e = 0; e < 4; ++e) { v0[e] = gelu_tanh_f(v0[e]); v1[e] = gelu_tanh_f(v1[e]); }
                    } else if (act == 4 || act == 5) {
                        const int t = row & (SEQ - 1); const int pos = (wc & 1) ? (t & 63) : (t >> 6); const int j0 = 16 * bj + 4 * fq;
                        const f32x4* rp = (const f32x4*)(rope + (size_t)(pos * 32 + j0) * 2); const f32x4 cs0 = rp[0], cs1 = rp[1];
                        f32x4 o0, o1;
                        o0[0] = v0[0] * cs0[0] - v0[1] * cs0[1]; o0[1] = v0[0] * cs0[1] + v0[1] * cs0[0];
                        o0[2] = v0[2] * cs0[2] - v0[3] * cs0[3]; o0[3] = v0[2] * cs0[3] + v0[3] * cs0[2];
                        o1[0] = v1[0] * cs1[0] - v1[1] * cs1[1]; o1[1] = v1[0] * cs1[1] + v1[1] * cs1[0];
                        o1[2] = v1[2] * cs1[2] - v1[3] * cs1[3]; o1[3] = v1[2] * cs1[3] + v1[3] * cs1[2];
                        v0 = o0 * ksc; v1 = o1 * ksc;
                    } else if (act == 6) { v0 = v0 * ksc; v1 = v1 * ksc; }
                    w[bj] = pack8(v0, v1);
                }
                u32x4 snd, rcv, d1, d2;
                snd.x = hi ? w[0].x : w[1].x; snd.y = hi ? w[0].y : w[1].y; snd.z = hi ? w[0].z : w[1].z; snd.w = hi ? w[0].w : w[1].w;
                rcv.x = (unsigned)__builtin_amdgcn_update_dpp(0, (int)snd.x, 0x128, 0xf, 0xf, false); rcv.y = (unsigned)__builtin_amdgcn_update_dpp(0, (int)snd.y, 0x128, 0xf, 0xf, false);
                rcv.z = (unsigned)__builtin_amdgcn_update_dpp(0, (int)snd.z, 0x128, 0xf, 0xf, false); rcv.w = (unsigned)__builtin_amdgcn_update_dpp(0, (int)snd.w, 0x128, 0xf, 0xf, false);
                d1.x = hi ? rcv.x : w[0].x; d1.y = hi ? rcv.y : w[0].y; d1.z = hi ? rcv.z : w[0].z; d1.w = hi ? rcv.w : w[0].w;
                d2.x = hi ? w[1].x : rcv.x; d2.y = hi ? w[1].y : rcv.y; d2.z = hi ? w[1].z : rcv.z; d2.w = hi ? w[1].w : rcv.w;
                bf16* p1 = O + (size_t)(rowg + (fr & 7)) * INW + col0 + wc * 64 + (hi ? 32 : 0) + 8 * fq;
                *(u32x4*)p1 = d1; *(u32x4*)(p1 + (size_t)8 * INW) = d2;
            }
    }
};
__device__ __forceinline__ size_t ablk(int r, int c, int K) { return ((size_t)(r >> 4) * (K >> 5) + (c >> 5)) * 1024 + (r & 15) * 64 + (c & 31) * 2; }
template <bool FL> struct EpiPlainT {
    static constexpr bool CHAIN = false; static constexpr int NSTORE = 16;
    bf16* O; int ldc; float scale; float* part;
    __device__ __forceinline__ void operator()(const f32x4 (&acc)[2][2][4][2], const Unit& u, int wr, int wc) const {
        unsigned em_ = ~0u; asm volatile("" : "+s"(em_)); const int el_ = (int)__builtin_amdgcn_mbcnt_hi(em_, __builtin_amdgcn_mbcnt_lo(em_, 0u)); const int fr = el_ & 15, fq = el_ >> 4;
        const int rowb = u.row0 + wr * 64 + fr, colb = u.col0 + (FL ? wc * 64 : wc * 32) + 8 * fq; constexpr int BJS = FL ? 32 : 128;
        if (u.z > 0) {
            float* pb = part + ((size_t)(u.z - 1) * RC + (rowb - RL)) * DM + colb;
#pragma unroll
            for (int ai = 0; ai < 2; ++ai)
#pragma unroll
                for (int m = 0; m < 4; ++m) { float* rowp = pb + (size_t)(ai * 128 + m * 16) * DM;
#pragma unroll
                    for (int bj = 0; bj < 2; ++bj) { *(f32x4*)(rowp + bj * BJS) = acc[ai][bj][m][0]; *(f32x4*)(rowp + bj * BJS + 4) = acc[ai][bj][m][1]; } }
            return;
        }
        if (FL) {
            const bool hi = fr >= 8;
#pragma unroll
            for (int ai = 0; ai < 2; ++ai)
#pragma unroll
                for (int m = 0; m < 4; ++m) {
                    const u32x4 w0 = pack8(acc[ai][0][m][0] * scale, acc[ai][0][m][1] * scale), w1 = pack8(acc[ai][1][m][0] * scale, acc[ai][1][m][1] * scale);
                    u32x4 snd, rcv, d1, d2;
                    snd.x = hi ? w0.x : w1.x; snd.y = hi ? w0.y : w1.y; snd.z = hi ? w0.z : w1.z; snd.w = hi ? w0.w : w1.w;
                    rcv.x = (unsigned)__builtin_amdgcn_update_dpp(0, (int)snd.x, 0x128, 0xf, 0xf, false); rcv.y = (unsigned)__builtin_amdgcn_update_dpp(0, (int)snd.y, 0x128, 0xf, 0xf, false);
                    rcv.z = (unsigned)__builtin_amdgcn_update_dpp(0, (int)snd.z, 0x128, 0xf, 0xf, false); rcv.w = (unsigned)__builtin_amdgcn_update_dpp(0, (int)snd.w, 0x128, 0xf, 0xf, false);
                    d1.x = hi ? rcv.x : w0.x; d1.y = hi ? rcv.y : w0.y; d1.z = hi ? rcv.z : w0.z; d1.w = hi ? rcv.w : w0.w;
                    d2.x = hi ? w1.x : rcv.x; d2.y = hi ? w1.y : rcv.y; d2.z = hi ? w1.z : rcv.z; d2.w = hi ? w1.w : rcv.w;
                    bf16* p1 = O + (size_t)(u.row0 + wr * 64 + ai * 128 + m * 16 + (fr & 7)) * ldc + colb + (hi ? 32 : 0);
                    *(u32x4*)p1 = d1; *(u32x4*)(p1 + (size_t)8 * ldc) = d2;
                }
            return;
        }
#pragma unroll
        for (int ai = 0; ai < 2; ++ai)
#pragma unroll
            for (int m = 0; m < 4; ++m) { bf16* rowp = O + (size_t)(rowb + ai * 128 + m * 16) * ldc + colb;
#pragma unroll
                for (int bj = 0; bj < 2; ++bj) *(u32x4*)(rowp + bj * 128) = pack8(acc[ai][bj][m][0] * scale, acc[ai][bj][m][1] * scale); }
    }
};
using EpiPlain = EpiPlainT<false>; using EpiPlainFL = EpiPlainT<true>;
struct EpiSwiglu {
    static constexpr bool CHAIN = false; static constexpr int NSTORE = 8;
    bf16* H;
    __device__ __forceinline__ void operator()(const f32x4 (&acc)[2][2][4][2], const Unit& u, int wr, int wc) const {
        unsigned em_ = ~0u; asm volatile("" : "+s"(em_)); const int el_ = (int)__builtin_amdgcn_mbcnt_hi(em_, __builtin_amdgcn_mbcnt_lo(em_, 0u)); const int fr = el_ & 15, fq = el_ >> 4;
        const int rowb = u.row0 + wr * 64 + fr, colb = (u.col0 >> 1) + wc * 32 + 8 * fq;
#pragma unroll
        for (int ai = 0; ai < 2; ++ai)
#pragma unroll
            for (int m = 0; m < 4; ++m) { bf16* rowp = (bf16*)((char*)H + ablk(rowb + ai * 128 + m * 16, colb, DFF));
                f32x4 v0 = acc[ai][0][m][0], v1 = acc[ai][0][m][1]; const f32x4 u0 = acc[ai][1][m][0], u1 = acc[ai][1][m][1];
#pragma unroll
                for (int e = 0; e < 4; ++e) { v0[e] = silu_f(v0[e]) * u0[e]; v1[e] = silu_f(v1[e]) * u1[e]; }
                *(u32x4*)rowp = pack8(v0, v1); }
    }
};
struct EpiMerge {
    static constexpr bool CHAIN = true; static constexpr int NSTORE = 0;
    const bf16* __restrict__ P; bf16* __restrict__ M;
    __device__ __forceinline__ bool chain(f32x4 (&acc)[2][2][4][2], const Unit& u, int wr, int wc) const {
        unsigned em_ = ~0u; asm volatile("" : "+s"(em_)); const int el_ = (int)__builtin_amdgcn_mbcnt_hi(em_, __builtin_amdgcn_mbcnt_lo(em_, 0u)); const int fr = el_ & 15, fq = el_ >> 4;
        const int rowb = u.row0 + wr * 64 + fr, colb = u.col0 + wc * 32 + 8 * fq, n = u.z;
        const bf16* gbase = P + (size_t)(u.row0 + 32 * (u.col0 >> 8) + 8 * n + wr * 4 + wc) * INW + GATE_OFF + (fr + 16 * fq) * 8;
        if (n < 3) {
#pragma unroll
            for (int ai = 0; ai < 2; ++ai)
#pragma unroll
                for (int mp = 0; mp < 2; ++mp) {
                    u32x4 gw[2][2];
#pragma unroll
                    for (int mm = 0; mm < 2; ++mm)
#pragma unroll
                        for (int bj = 0; bj < 2; ++bj) gw[mm][bj] = *(const u32x4*)(gbase + ((ai * 4 + 2 * mp + mm) * 2 + bj) * 512);
#pragma unroll
                    for (int mm = 0; mm < 2; ++mm)
#pragma unroll
                        for (int bj = 0; bj < 2; ++bj) { const u32x4 g = gw[mm][bj]; const int m = 2 * mp + mm;
                            acc[ai][bj][m][0] *= (f32x4){bflo(g.x), bfhi(g.x), bflo(g.y), bfhi(g.y)}; acc[ai][bj][m][1] *= (f32x4){bflo(g.z), bfhi(g.z), bflo(g.w), bfhi(g.w)}; }
                }
            return true;
        }
#pragma unroll
        for (int ai = 0; ai < 2; ++ai) {
            u32x4 gw[4][2];
#pragma unroll
            for (int m = 0; m < 4; ++m)
#pragma unroll
                for (int bj = 0; bj < 2; ++bj) gw[m][bj] = *(const u32x4*)(gbase + ((ai * 4 + m) * 2 + bj) * 512);
#pragma unroll
            for (int m = 0; m < 4; ++m)
#pragma unroll
                for (int bj = 0; bj < 2; ++bj) { const u32x4 g = gw[m][bj];
                    const f32x4 s0 = (f32x4){bflo(g.x), bfhi(g.x), bflo(g.y), bfhi(g.y)}, s1 = (f32x4){bflo(g.z), bfhi(g.z), bflo(g.w), bfhi(g.w)};
                    *(u32x4*)((char*)M + ablk(rowb + ai * 128 + m * 16, colb + bj * 128, DM)) = pack8(acc[ai][bj][m][0] * s0, acc[ai][bj][m][1] * s1); }
        }
        return false;
    }
};

template <int NN> struct TileSched {
    int nlat, ntot, cpn0, G, c, nt, ksplit, colbase, kstepB, kstepA; const char* A; const char* B; size_t at, bt;
    __device__ __forceinline__ void init(int cpn0_, int cnN, int G_, int c_, const void* A_, size_t at_, const void* B_, size_t bt_, int nt_, int ksplit_ = 1, int colbase_ = 0, int kstepB_ = 128, int kstepA_ = 128) {
        kstepA = kstepA_; kstepB = kstepB_; colbase = colbase_; nlat = 128 * NN; ntot = nlat + 8 * cnN * ksplit_; cpn0 = cpn0_; G = G_; c = c_; A = (const char*)A_; B = (const char*)B_; at = at_; bt = bt_; nt = nt_; ksplit = ksplit_; }
    __device__ __forceinline__ bool next(int i, Unit& u) const {
        const int L = i * G + c; if (L >= ntot) return false; int pm, pn; size_t koff = 0, koffB = 0; u.z = 0; u.nt = nt;
        if (L < nlat) pg8::map_tile<128, NN>(L, pm, pn);
        else if (ksplit == 1) { const int r = L - nlat; pm = 128 + (r & 7); pn = cpn0 + (r >> 3); }
        else { const int r = L - nlat, ks = r & 3, tl = r >> 2; pm = 128 + (tl & 7); pn = cpn0 + (tl >> 3); u.nt = nt >> 2; u.z = 1 + ks; koff = (size_t)ks * (nt >> 2) * kstepA; koffB = (size_t)ks * (nt >> 2) * kstepB; }
        u.row0 = pm * 256; u.col0 = colbase + pn * 256; u.a = A + (size_t)pm * at + koff; u.b = B + (size_t)pn * bt + koffB; return true; }
};
struct YSched {
    int nM, ntiles, G, c; const char* A; const char* B;
    __device__ __forceinline__ bool next(int i, Unit& u) const {
        const int j = i >> 2, n = i & 3, T = j * G + c; if (T >= ntiles) return false; int pm, pn;
        if (G == 256) { const int x = c & 7, lc = c >> 3; pn = lc & 7; pm = (j < 4) ? 32 * j + 4 * x + (lc >> 3) : 128 + x; }
        else { pn = T & 7; pm = T >> 3; }
        u.row0 = pm * 256; u.col0 = pn * 256; u.z = n; u.nt = MIXW / 64; u.a = A + ((size_t)pm * 256 * DM + n * MIXW) * 2; u.b = B + ((size_t)(n * DM + pn * 256) * MIXW) * 2; return true; }
};
struct DftSchedL {
    int G, c; const char* A; const char* B;
    __device__ __forceinline__ bool next(int i, Unit& u) const {
        const int L = i * G + c; if (L >= 256) return false;
        const int x = L & 7, li = L >> 3, pm = 4 * (x & 3) + (li & 3), bn = li >> 2, b = 4 * (x >> 2) + (bn >> 1), pn = bn & 1;
        u.row0 = b * SEQ + pm * 256; u.col0 = MIXW + pn * 256; u.z = 0; u.nt = 4096 / 64; u.a = A + (size_t)pm * 256 * 4096 * 2; u.b = B + ((size_t)(b * 512 + pn * 256) * 4096) * 2; return true; }
};
struct DftSchedC {
    int G, c; const char* A; const char* B;
    __device__ __forceinline__ bool next(int i, Unit& u) const {
        const int L = i * G + c; if (L >= 16) return false; const int b = L >> 1, pn = L & 1;
        u.row0 = RL + b * CTXL; u.col0 = MIXW + pn * 256; u.z = 0; u.nt = 512 / 64; u.a = A; u.b = B + ((size_t)(b * 512 + pn * 256) * 512) * 2; return true; }
};

struct Frame {
    LAS unsigned char* lds; int tid, lane, wave, G, c;
    unsigned char* ws; const float* in[16]; float* out;
};
__device__ __forceinline__ float wave_sum(float v) {
#pragma unroll
    for (int o = 1; o < 64; o <<= 1) v += __shfl_xor(v, o);
    return v;
}
__device__ __forceinline__ int chunk_row(int b, int ci) { return ci < 2 ? RL + b * CTXL + ci * 128 : b * SEQ + (ci - 2) * 128; }
__device__ __forceinline__ void decode_item(int it, bool lat_only, int& b, int& h, int& ci) {
    if (lat_only) { b = it >> 7; const int r = it & 127; h = r >> 5; ci = 2 + (r & 31); }
    else { b = it / 136; const int r = it % 136; h = r / NCH; ci = r % NCH; }
}

__device__ __forceinline__ int dst_row(int kind, int n) {
    if (kind == 0 && n < GATE_OFF) { int c = n; if (n < 2 * MIXW) { const int i = n & 127, hh = i >> 6, ii = i & 63, e = ii >> 5, j = ii & 31; c = (n & ~127) + 64 * hh + 2 * j + e; }
        return (c & ~255) + 128 * ((c >> 5) & 1) + 32 * ((c >> 6) & 3) + (c & 31); }
    if (kind == 0) {
        if (n >= GATE_OFF) { const int gc = n - GATE_OFF, gn = gc >> 11, d = gc & (DM - 1), pg = d >> 6, dl = d & 63, fq = 2 * ((dl >> 2) & 1) + ((dl >> 3) & 1);
            return GATE_OFF + 256 * pg + 128 * (gn >> 1) + 32 * (dl >> 4) + 8 * fq + 4 * (gn & 1) + (dl & 3); }
        return n; }
    if (kind == 3) return (n & ~255) + 128 * ((n >> 5) & 1) + 32 * ((n >> 6) & 3) + (n & 31);
    if (kind == 2) { if (n < DFF) return 256 * (n >> 7) + (n & 127); const int m = n - DFF; return 256 * (m >> 7) + 128 + (m & 127); }
    return n;
}
__device__ __forceinline__ size_t blk_off(int n, int kb, int kbytes) {
    const int q = n & 31, s = (n & ~31) + 16 * ((q >> 2) & 1) + 4 * (q >> 3) + (q & 3);
    return ((size_t)(s >> 4) * (kbytes >> 6) + (kb >> 6)) * 1024 + (s & 15) * 64 + (kb & 63);
}
__device__ __forceinline__ void cv_load_tile(const float* W, int N, int k0, int n0, LAS float* scr, int lane) {
    const int r8 = lane >> 3, cq = lane & 7; f32x4 v[8];
#pragma unroll
    for (int i = 0; i < 8; ++i) v[i] = *(const f32x4*)(W + (size_t)(k0 + 8 * i + r8) * N + n0 + 4 * cq);
#pragma unroll
    for (int i = 0; i < 8; ++i) { LAS float* d = scr + (8 * i + r8) * 33 + 4 * cq; d[0] = v[i][0]; d[1] = v[i][1]; d[2] = v[i][2]; d[3] = v[i][3]; }
    asm volatile("s_waitcnt lgkmcnt(0)" ::: "memory");
}
__device__ __forceinline__ void transpose_item(const float* W, int K, int N, bf16* WT, int kind, LAS float* scr, int item, int lane) {
    const int nblk = N / 32, kb = item / nblk, nb = item % nblk, k0 = 64 * kb, n0 = 32 * nb;
    cv_load_tile(W, N, k0, n0, scr, lane);
    const int c = lane & 7;
#pragma unroll
    for (int j = 0; j < 4; ++j) { const int n = (lane >> 3) + 8 * j; const LAS float* s = scr + (8 * c) * 33 + n;
        u32x4 o; o.x = pk2(s[0 * 33], s[1 * 33]); o.y = pk2(s[2 * 33], s[3 * 33]); o.z = pk2(s[4 * 33], s[5 * 33]); o.w = pk2(s[6 * 33], s[7 * 33]);
        *(u32x4*)((unsigned char*)WT + blk_off(dst_row(kind, n0 + n), 2 * (k0 + 8 * c), 2 * K)) = o; }
    asm volatile("s_waitcnt lgkmcnt(0)" ::: "memory");
}
__device__ __forceinline__ void transpose_item_fp8(const float* W, int K, int N, unsigned char* W8, LAS float* scr, int item, int lane) {
    const int nblk = N / 32, kb = item / nblk, nb = item % nblk, k0 = 64 * kb, n0 = 32 * nb;
    cv_load_tile(W, N, k0, n0, scr, lane);
    const int c = lane & 7;
#pragma unroll
    for (int j = 0; j < 4; ++j) { const int n = (lane >> 3) + 8 * j; const LAS float* s = scr + (8 * c) * 33 + n;
        unsigned lo = 0u, hi = 0u;
        lo = __builtin_amdgcn_cvt_pk_fp8_f32(s[0 * 33] * 64.f, s[1 * 33] * 64.f, lo, false); lo = __builtin_amdgcn_cvt_pk_fp8_f32(s[2 * 33] * 64.f, s[3 * 33] * 64.f, lo, true);
        hi = __builtin_amdgcn_cvt_pk_fp8_f32(s[4 * 33] * 64.f, s[5 * 33] * 64.f, hi, false); hi = __builtin_amdgcn_cvt_pk_fp8_f32(s[6 * 33] * 64.f, s[7 * 33] * 64.f, hi, true);
        u32x2 o; o.x = lo; o.y = hi;
        *(u32x2*)(W8 + blk_off(dst_row(0, n0 + n) - GATE_OFF, k0 + 8 * c, K)) = o; }
    asm volatile("s_waitcnt lgkmcnt(0)" ::: "memory");
}
constexpr int CV_WIN = (DM / 64) * (INW / 32), CV_BR1 = (MIXW / 64) * (DM / 32), CV_WO = (DM / 64) * (DM / 32), CV_W1 = (DM / 64) * (2 * DFF / 32), CV_W2 = (DFF / 64) * (DM / 32);
constexpr int CV_TOTAL = CV_WIN + 4 * CV_BR1 + CV_WO + CV_W1 + CV_W2;
constexpr int CV_SCR_OFF = 73728;
__device__ __forceinline__ void convert_weights(Frame& F, int l, int lo, int hi, int w0, int nw) {
    LAS float* scr = (LAS float*)(F.lds + CV_SCR_OFF + F.wave * 8448);
    const int gw = (F.c - w0) * NWAVES + F.wave, NGW = nw * NWAVES;
    for (int it = lo + gw; it < hi; it += NGW) {
        int r = it;
        if (r < CV_WIN) { if ((r % (INW / 32)) * 32 >= GATE_OFF) transpose_item_fp8(F.in[7] + (size_t)l * DM * INW, DM, INW, F.ws + WS_WIN + (size_t)GATE_OFF * DM * 2, scr, r, F.lane);
            else transpose_item(F.in[7] + (size_t)l * DM * INW, DM, INW, (bf16*)(F.ws + WS_WIN), 0, scr, r, F.lane); continue; } r -= CV_WIN;
        if (r < 4 * CV_BR1) { const int n = r / CV_BR1; transpose_item(F.in[12] + (size_t)(l * 4 + n) * MIXW * DM, MIXW, DM, (bf16*)(F.ws + WS_WBR) + (size_t)n * DM * MIXW, 1, scr, r % CV_BR1, F.lane); continue; } r -= 4 * CV_BR1;
        if (r < CV_WO) { transpose_item(F.in[13] + (size_t)l * DM * DM, DM, DM, (bf16*)(F.ws + WS_WOUT), 3, scr, r, F.lane); continue; } r -= CV_WO;
        if (r < CV_W1) { transpose_item(F.in[14] + (size_t)l * DM * 2 * DFF, DM, 2 * DFF, (bf16*)(F.ws + WS_W1), 2, scr, r, F.lane); continue; } r -= CV_W1;
        transpose_item(F.in[15] + (size_t)l * DFF * DM, DFF, DM, (bf16*)(F.ws + WS_W2), 3, scr, r, F.lane);
    }
}

__device__ __forceinline__ void p0_body(Frame& F) {
    LAS float* sc = (LAS float*)F.lds;
    for (int idx = F.tid; idx < NCOND * DM; idx += NTHR) { const int j = idx >> 11, k = idx & (DM - 1); const float v = (j < NB) ? F.in[1][j * DM + k] : F.in[3][k]; sc[idx] = v / (1.f + expf(-v)); }
    __syncthreads();
    const int gw = F.c * NWAVES + F.wave, NGW = F.G * NWAVES;
    float* modp = (float*)(F.ws + WS_MODP);
    for (int it = gw; it < DEPTH * 48 * 8; it += NGW) {
        const int l = it / 384, r = it % 384, cb = r >> 3, ks = r & 7, n = cb * 256 + 4 * F.lane;
        f32x4 acc[NCOND];
#pragma unroll
        for (int j = 0; j < NCOND; ++j) acc[j] = (f32x4){0.f, 0.f, 0.f, 0.f};
        const float* wp = F.in[4] + ((size_t)l * DM + ks * 256) * ADAW + n;
        for (int k = 0; k < 256; k += 4) {
            f32x4 w[4];
#pragma unroll
            for (int kk = 0; kk < 4; ++kk) w[kk] = *(const f32x4*)(wp + (size_t)(k + kk) * ADAW);
#pragma unroll
            for (int kk = 0; kk < 4; ++kk)
#pragma unroll
                for (int j = 0; j < NCOND; ++j) acc[j] += w[kk] * sc[j * DM + ks * 256 + k + kk];
        }
#pragma unroll
        for (int j = 0; j < NCOND; ++j) *(f32x4*)(modp + ((size_t)((l * 8 + ks) * NCOND + j)) * ADAW + n) = acc[j];
    }
    convert_weights(F, 0, 0, F.G == 256 ? CV_WIN : CV_TOTAL, 0, F.G);
    __syncthreads();
    const int gt = F.c * NTHR + F.tid, NGT = F.G * NTHR;
    float* rope = (float*)(F.ws + WS_TAB);
    for (int idx = gt; idx < 64 * 32; idx += NGT) { const int pos = idx >> 5, j = idx & 31; const float fr = powf(10000.f, -(float)(2 * j) / 64.f); const float a = (float)pos * fr; rope[2 * idx] = cosf(a); rope[2 * idx + 1] = sinf(a); }
    LAS float* ct = (LAS float*)F.lds;
    for (int i = F.tid; i < 4096; i += NTHR) ct[i] = cospif((float)i * (1.f / 2048.f));
    __syncthreads();
    bf16* dl = (bf16*)(F.ws + WS_DFTL);
    for (int idx = gt; idx < 4096 * 512; idx += NGT) { const int k = idx >> 9, j8 = (idx & 511) * 8; const int tb = j8 & 2047; const bool sn = j8 >= 2048;
        float v[8];
#pragma unroll
        for (int e = 0; e < 8; ++e) { const int t = tb + e; v[e] = !sn ? ct[(k * t) & 4095] : (t == 0 ? ct[(k * 2048) & 4095] : ct[(k * t + 1024) & 4095]); }
        u32x4 o; o.x = pk2(v[0], v[1]); o.y = pk2(v[2], v[3]); o.z = pk2(v[4], v[5]); o.w = pk2(v[6], v[7]);
        *(u32x4*)(dl + (size_t)k * 4096 + j8) = o; }
    bf16* dm = (bf16*)(F.ws + WS_TAB + 65536);
    for (int idx = gt; idx < 256 * 128; idx += NGT) { const int cp = idx >> 7, c = idx & 127; const int m = (c * (cp & 127)) & 127; dm[idx] = (bf16)f2bf(ct[(m * 32 + (cp >= 128 ? 3072 : 0)) & 4095]); }
    bf16* dc = (bf16*)(F.ws + WS_DFTC);
    for (int idx = gt; idx < 256 * 64; idx += NGT) { const int k = idx >> 6, t8 = (idx & 63) * 8; const int tb = t8 & 255, ph = (t8 >= 256) ? 1024 : 0;
        float v[8];
#pragma unroll
        for (int e = 0; e < 8; ++e) v[e] = ct[((((k * (tb + e)) & 255) << 4) + ph) & 4095];
        u32x4 o; o.x = pk2(v[0], v[1]); o.y = pk2(v[2], v[3]); o.z = pk2(v[4], v[5]); o.w = pk2(v[6], v[7]);
        *(u32x4*)(dc + (size_t)k * 512 + t8) = o; }
}
__device__ __forceinline__ void p0b_body(Frame& F) {
    const int gt = F.c * NTHR + F.tid, NGT = F.G * NTHR;
    const float* modp = (const float*)(F.ws + WS_MODP); float* mod = (float*)(F.ws + WS_MOD);
    for (int idx = gt; idx < DEPTH * NCOND * ADAW; idx += NGT) { const int n = idx % ADAW, lj = idx / ADAW, j = lj % NCOND, l = lj / NCOND;
        float s = F.in[5][l * ADAW + n];
#pragma unroll
        for (int ks = 0; ks < 8; ++ks) s += modp[((size_t)((l * 8 + ks) * NCOND + j)) * ADAW + n];
        mod[idx] = s; }
}

struct RowPass {
    const float* xl_in; const float* xc_in; float* xl_out; float* xc_out;
    const bf16* Y;
    const float* gy; int gate_off;
    const float* gx; int shift_off, scale_off; int lnext;
    int l; bool do_ctx; bf16* HX;
    unsigned char* HX8;
    const float* part;
    const bf16* Y0; const float* gy0; int gate0_off;
};
__device__ __forceinline__ void row_block(Frame& F, const RowPass& P, int row0, int nrows, int cond, const float* xin, float* xout, int xrow0) {
    LAS float* V = (LAS float*)F.lds;
    const float* mod = (const float*)(F.ws + WS_MOD);
    const bool pre = P.Y0 != nullptr && row0 < RL;
    __syncthreads();
    for (int i = F.tid; i < DM; i += NTHR) {
        V[i] = P.Y ? mod[((size_t)(P.l * NCOND + cond)) * ADAW + P.gate_off + i] * P.gy[i] : 0.f;
        if (pre) V[3 * DM + i] = mod[((size_t)(P.l * NCOND + cond)) * ADAW + P.gate0_off + i] * P.gy0[i];
        if (P.lnext >= 0) { const float* mn = mod + ((size_t)(P.lnext * NCOND + cond)) * ADAW; V[DM + i] = P.gx[i] * (1.f + mn[P.scale_off + i]); V[2 * DM + i] = mn[P.shift_off + i]; }
    }
    __syncthreads();
    for (int rr = F.wave; rr < nrows; rr += NWAVES) {
        const int row = row0 + rr; const size_t xo = (size_t)(row - xrow0) * DM;
        f32x4 xv[8];
#pragma unroll
        for (int j = 0; j < 8; ++j) xv[j] = *(const f32x4*)(xin + xo + j * 256 + 4 * F.lane);
        if (pre) {
            f32x4 yv[8]; float ss = 0.f;
#pragma unroll
            for (int j = 0; j < 8; ++j) { const u32x2 yw = *(const u32x2*)(P.Y0 + (size_t)row * DM + j * 256 + 4 * F.lane); yv[j] = (f32x4){bflo(yw.x), bfhi(yw.x), bflo(yw.y), bfhi(yw.y)}; }
#pragma unroll
            for (int j = 0; j < 8; ++j) ss += (yv[j][0] * yv[j][0] + yv[j][1] * yv[j][1]) + (yv[j][2] * yv[j][2] + yv[j][3] * yv[j][3]);
            const float rstd = __builtin_amdgcn_rsqf(wave_sum(ss) * (1.f / DM) + EPS);
#pragma unroll
            for (int j = 0; j < 8; ++j) { const f32x4 va = *(const LAS f32x4*)(V + 3 * DM + j * 256 + 4 * F.lane); xv[j] += va * (yv[j] * rstd); }
        }
        if (P.Y) {
            f32x4 yv[8]; float ss = 0.f;
            if (P.part && row >= RL) {
#pragma unroll
                for (int j = 0; j < 8; ++j) { const float* pp = P.part + (size_t)(row - RL) * DM + j * 256 + 4 * F.lane;
                    yv[j] = (*(const f32x4*)pp + *(const f32x4*)(pp + (size_t)RC * DM)) + (*(const f32x4*)(pp + (size_t)2 * RC * DM) + *(const f32x4*)(pp + (size_t)3 * RC * DM)); }
            } else {
#pragma unroll
                for (int j = 0; j < 8; ++j) { const u32x2 yw = *(const u32x2*)(P.Y + (size_t)row * DM + j * 256 + 4 * F.lane); yv[j] = (f32x4){bflo(yw.x), bfhi(yw.x), bflo(yw.y), bfhi(yw.y)}; }
            }
#pragma unroll
            for (int j = 0; j < 8; ++j) ss += (yv[j][0] * yv[j][0] + yv[j][1] * yv[j][1]) + (yv[j][2] * yv[j][2] + yv[j][3] * yv[j][3]);
            const float rstd = __builtin_amdgcn_rsqf(wave_sum(ss) * (1.f / DM) + EPS);
#pragma unroll
            for (int j = 0; j < 8; ++j) { const f32x4 va = *(const LAS f32x4*)(V + j * 256 + 4 * F.lane);
                xv[j] += va * (yv[j] * rstd);
                if (xout) *(f32x4*)(xout + xo + j * 256 + 4 * F.lane) = xv[j]; }
        }
        if (P.lnext >= 0) {
            float ss = 0.f;
#pragma unroll
            for (int j = 0; j < 8; ++j) ss += (xv[j][0] * xv[j][0] + xv[j][1] * xv[j][1]) + (xv[j][2] * xv[j][2] + xv[j][3] * xv[j][3]);
            const float rstd = __builtin_amdgcn_rsqf(wave_sum(ss) * (1.f / DM) + EPS);
#pragma unroll
            for (int j = 0; j < 8; ++j) { const f32x4 vb = *(const LAS f32x4*)(V + DM + j * 256 + 4 * F.lane), vc = *(const LAS f32x4*)(V + 2 * DM + j * 256 + 4 * F.lane);
                const f32x4 h = xv[j] * rstd * vb + vc; u32x2 o; o.x = pk2(h[0], h[1]); o.y = pk2(h[2], h[3]);
                *(u32x2*)(P.HX + (size_t)row * DM + j * 256 + 4 * F.lane) = o;
                if (P.HX8) { unsigned w8 = 0u; w8 = __builtin_amdgcn_cvt_pk_fp8_f32(h[0], h[1], w8, false); w8 = __builtin_amdgcn_cvt_pk_fp8_f32(h[2], h[3], w8, true); *(unsigned*)(P.HX8 + (size_t)row * DM + j * 256 + 4 * F.lane) = w8; } }
        }
    }
}
__device__ __forceinline__ void row_pass(Frame& F, const RowPass& P) {
    for (int blk = F.c; blk < RL / 128; blk += F.G) row_block(F, P, blk * 128, 128, (blk * 128) / SEQ, P.xl_in, P.xl_out, 0);
    if (P.do_ctx) for (int blk = F.c; blk < RC / 8; blk += F.G) row_block(F, P, RL + blk * 8, 8, NB, P.xc_in, P.xc_out, RL);
    __syncthreads();
}

__device__ __forceinline__ void conv_body(Frame& F, int l, int nrows) {
    const bf16* P = (const bf16*)(F.ws + WS_PROJ); bf16* BR = (bf16*)(F.ws + WS_BUFB); const float* cw = F.in[9] + (size_t)l * 3 * MIXW;
    const int gt = F.c * NTHR + F.tid, NGT = F.G * NTHR, N = nrows * 64;
    const int c8 = (gt & 63) * 8;
    f32x4 w[3][2];
#pragma unroll
    for (int k = 0; k < 3; ++k) { w[k][0] = *(const f32x4*)(cw + k * MIXW + c8); w[k][1] = *(const f32x4*)(cw + k * MIXW + c8 + 4); }
#define CVL(id, C, X, Bw) do { const int r_ = (id) >> 6; bool l_, h_; \
        if (r_ < RL) { const int col = r_ & 63; l_ = col > 0; h_ = col < 63; } else { const int t = (r_ - RL) & (CTXL - 1); l_ = t > 0; h_ = t < CTXL - 1; } \
        const bf16* pr_ = P + (size_t)r_ * INW + c8; \
        C[0] = *(const u32x4*)((l_ ? pr_ - INW : pr_) + SCC_OFF); X[0] = *(const u32x4*)((l_ ? pr_ - INW : pr_) + SCX_OFF); \
        C[1] = *(const u32x4*)(pr_ + SCC_OFF); X[1] = *(const u32x4*)(pr_ + SCX_OFF); \
        C[2] = *(const u32x4*)((h_ ? pr_ + INW : pr_) + SCC_OFF); X[2] = *(const u32x4*)((h_ ? pr_ + INW : pr_) + SCX_OFF); \
        Bw = *(const u32x4*)(pr_ + SCB_OFF); } while (0)
    u32x4 cn[3], xn[3], bn;
#pragma unroll
    for (int k = 0; k < 3; ++k) { cn[k] = (u32x4){0u, 0u, 0u, 0u}; xn[k] = cn[k]; }
    bn = (u32x4){0u, 0u, 0u, 0u};
    if (gt < N) CVL(gt, cn, xn, bn);
    for (int idx = gt; idx < N; idx += NGT) {
        const int r = idx >> 6; bool hl, hr;
        if (r < RL) { const int col = r & 63; hl = col > 0; hr = col < 63; } else { const int t = (r - RL) & (CTXL - 1); hl = t > 0; hr = t < CTXL - 1; }
        u32x4 cv[3], xv[3]; const u32x4 b = bn;
#pragma unroll
        for (int k = 0; k < 3; ++k) { cv[k] = cn[k]; xv[k] = xn[k]; }
        if (idx + NGT < N) CVL(idx + NGT, cn, xn, bn);
        f32x4 a0 = (f32x4){0.f, 0.f, 0.f, 0.f}, a1 = a0;
#pragma unroll
        for (int k = 0; k < 3; ++k) { const bool ok = (k == 1) || (k == 0 ? hl : hr); const u32x4 c = cv[k], x = xv[k]; const float m = ok ? 1.f : 0.f;
            const f32x4 y0 = (f32x4){bflo(c.x) * bflo(x.x), bfhi(c.x) * bfhi(x.x), bflo(c.y) * bflo(x.y), bfhi(c.y) * bfhi(x.y)}, y1 = (f32x4){bflo(c.z) * bflo(x.z), bfhi(c.z) * bfhi(x.z), bflo(c.w) * bflo(x.w), bfhi(c.w) * bfhi(x.w)};
            a0 += w[k][0] * (y0 * m); a1 += w[k][1] * (y1 * m); }
        const f32x4 o0 = (f32x4){bflo(b.x), bfhi(b.x), bflo(b.y), bfhi(b.y)} * a0, o1 = (f32x4){bflo(b.z), bfhi(b.z), bflo(b.w), bfhi(b.w)} * a1;
        u32x4 ow; ow.x = pk2(o0[0], o0[1]); ow.y = pk2(o0[2], o0[3]); ow.z = pk2(o1[0], o1[1]); ow.w = pk2(o1[2], o1[3]);
        *(u32x4*)(BR + (size_t)r * DM + 3 * MIXW + c8) = ow;
    }
#undef CVL
}
__device__ __forceinline__ void scan_body(Frame& F, int l) {
    const bf16* DS = (const bf16*)(F.ws + WS_BUFA); bf16* ST = (bf16*)(F.ws + WS_ST);
    const int gt = F.c * NTHR + F.tid, NGT = F.G * NTHR;
    for (int idx = gt; idx < NB * NGRP * 2 * (GD * GD / 4); idx += NGT) {
        const int e4 = (idx & (GD * GD / 4 - 1)) * 4, bhd = __builtin_amdgcn_readfirstlane(idx >> 12), dir = bhd & 1, h = (bhd >> 1) & 3;
        const float cd = __expf(F.in[8][(l * 2 + dir) * NGRP + h] * 128.f);
        const size_t base = (size_t)bhd * NCH * (GD * GD);
        f32x4 s = (f32x4){0.f, 0.f, 0.f, 0.f};
#pragma unroll
        for (int hb = 0; hb < 1; ++hb) {
            u32x2 dw[NCH];
#pragma unroll
            for (int k = 0; k < NCH; ++k) { const int st = k, ci = (dir == 0) ? st : (st < 2 ? 1 - st : NCH + 1 - st); dw[k] = *(const u32x2*)(DS + base + (size_t)ci * (GD * GD) + e4); }
#pragma unroll
            for (int k = 0; k < NCH; ++k) {
                const int st = k, ci = (dir == 0) ? st : (st < 2 ? 1 - st : NCH + 1 - st);
                u32x2 o; o.x = pk2(s[0], s[1]); o.y = pk2(s[2], s[3]); *(u32x2*)(ST + base + (size_t)ci * (GD * GD) + e4) = o;
                const f32x4 d = (f32x4){bflo(dw[k].x), bfhi(dw[k].x), bflo(dw[k].y), bfhi(dw[k].y)};
                s = s * cd + d;
            }
        }
    }
}

typedef short s16x4 __attribute__((ext_vector_type(4)));
typedef short bf16x8 __attribute__((ext_vector_type(8)));
__device__ __forceinline__ unsigned lds_addr(const LAS void* p) { return (unsigned)(size_t)p; }
template <int PITCH> __device__ __forceinline__ void load_tile_p(LAS bf16* dst, const bf16* src, size_t ld, int tid) {
#pragma unroll
    for (int i = 0; i < 4; ++i) { const int idx = tid + 512 * i, row = idx >> 4, ch = idx & 15;
        const u32x4 v = *(const u32x4*)(src + (size_t)row * ld + ch * 8); *(LAS u32x4*)(dst + row * PITCH + ch * 8) = v; }
}
template <int OFF0, int OFF1> __device__ __forceinline__ void tr_pair(s16x4& lo, s16x4& hi, unsigned addr) {
    asm volatile("ds_read_b64_tr_b16 %0, %2 offset:%3\n\tds_read_b64_tr_b16 %1, %2 offset:%4" : "=&v"(lo), "=&v"(hi) : "v"(addr), "i"(OFF0), "i"(OFF1) : "memory");
}
template <int R2> __device__ __forceinline__ void tr_frags8(s16x4 (&lo)[8], s16x4 (&hi)[8], unsigned addr) {
    tr_pair<0, R2>(lo[0], hi[0], addr); tr_pair<32, 32 + R2>(lo[1], hi[1], addr); tr_pair<64, 64 + R2>(lo[2], hi[2], addr); tr_pair<96, 96 + R2>(lo[3], hi[3], addr);
    tr_pair<128, 128 + R2>(lo[4], hi[4], addr); tr_pair<160, 160 + R2>(lo[5], hi[5], addr); tr_pair<192, 192 + R2>(lo[6], hi[6], addr); tr_pair<224, 224 + R2>(lo[7], hi[7], addr);
    asm volatile("s_waitcnt lgkmcnt(0)" ::: "memory"); __builtin_amdgcn_sched_barrier(0);
}
#define FRAG8(lo, hi, i) __builtin_shufflevector(lo[i], hi[i], 0, 1, 2, 3, 4, 5, 6, 7)
#define MFMA16(a, b, c) __builtin_amdgcn_mfma_f32_16x16x32_bf16(a, b, c, 0, 0, 0)

__device__ __forceinline__ void ret_item_mfma(Frame& F, int l, int it, bool lat_only) {
    int b, h, ci; decode_item(it, lat_only, b, h, ci);
    const bf16* P = (const bf16*)(F.ws + WS_PROJ); const int row0 = chunk_row(b, ci);
    LAS bf16* QS = (LAS bf16*)F.lds; LAS bf16* KS = (LAS bf16*)(F.lds + 34816); LAS bf16* VS = (LAS bf16*)(F.lds + 71680); LAS bf16* SF = (LAS bf16*)(F.lds + 108544); LAS bf16* SB = KS;
    const float lgf = F.in[8][(l * 2 + 0) * NGRP + h], lgb = F.in[8][(l * 2 + 1) * NGRP + h];
    const bf16* ST = (const bf16*)(F.ws + WS_ST) + ((size_t)(((b * NGRP + h) * 2 + 0) * NCH + ci)) * (GD * GD);
    __syncthreads();
    load_tile_p<136>(QS, P + (size_t)row0 * INW + Q_OFF + h * GD, INW, F.tid);
    load_tile_p<136>(KS, P + (size_t)row0 * INW + K_OFF + h * GD, INW, F.tid);
    load_tile_p<144>(VS, P + (size_t)row0 * INW + V_OFF + h * GD, INW, F.tid);
    load_tile_p<144>(SF, ST, GD, F.tid);
    __syncthreads();
    int lane_ = F.lane; asm volatile("" : "+v"(lane_));
    const int w = F.wave, g = lane_ >> 4, n = lane_ & 15, q4 = n >> 2, p4 = n & 3;
    bf16x8 qf[4];
#pragma unroll
    for (int ks = 0; ks < 4; ++ks) qf[ks] = *(const LAS bf16x8*)(QS + (16 * w + n) * 136 + 32 * ks + 8 * g);
    bf16x8 pf[4];
    {
        f32x4 s[8];
#pragma unroll
        for (int jt = 0; jt < 8; ++jt) { s[jt] = (f32x4){0.f, 0.f, 0.f, 0.f};
#pragma unroll
            for (int ks = 0; ks < 4; ++ks) { const bf16x8 kf = *(const LAS bf16x8*)(KS + (16 * jt + n) * 136 + 32 * ks + 8 * g); s[jt] = MFMA16(kf, qf[ks], s[jt]); }
            if (jt & 1) __builtin_amdgcn_sched_barrier(0); }
        const int ic = 16 * w + n;
#pragma unroll
        for (int jb = 0; jb < 4; ++jb) { unsigned wds[4];
#pragma unroll
            for (int hf = 0; hf < 2; ++hf) { float v[4];
#pragma unroll
                for (int r = 0; r < 4; ++r) { const int d = ic - (16 * (2 * jb + hf) + 4 * g + r); const float e = __expf(((d > 0) ? lgf : lgb) * fabsf((float)d)); v[r] = s[2 * jb + hf][r] * ((d == 0) ? 2.f : e); }
                wds[2 * hf] = pk2(v[0], v[1]); wds[2 * hf + 1] = pk2(v[2], v[3]); }
            pf[jb] = __builtin_bit_cast(bf16x8, (u32x4){wds[0], wds[1], wds[2], wds[3]}); }
    }
    __syncthreads();
    load_tile_p<144>(SB, ST + (size_t)NCH * GD * GD, GD, F.tid);
    f32x4 o[8], cf[8], cb[8];
#pragma unroll
    for (int e = 0; e < 8; ++e) { o[e] = (f32x4){0.f, 0.f, 0.f, 0.f}; cf[e] = o[e]; cb[e] = o[e]; }
    {
        const unsigned va = lds_addr(VS) + (unsigned)((4 * g + q4) * 288 + p4 * 8);
#pragma unroll
        for (int jb = 0; jb < 4; ++jb) { s16x4 lo[8], hi[8]; tr_frags8<16 * 288>(lo, hi, va + jb * 32 * 288);
#pragma unroll
            for (int e = 0; e < 8; ++e) o[e] = MFMA16(FRAG8(lo, hi, e), pf[jb], o[e]); }
        const unsigned sa = lds_addr(SF) + (unsigned)((8 * g + q4) * 288 + p4 * 8);
#pragma unroll
        for (int ks = 0; ks < 4; ++ks) { s16x4 lo[8], hi[8]; tr_frags8<4 * 288>(lo, hi, sa + ks * 32 * 288);
#pragma unroll
            for (int e = 0; e < 8; ++e) cf[e] = MFMA16(FRAG8(lo, hi, e), qf[ks], cf[e]); }
    }
    __syncthreads();
    {
        const unsigned sa = lds_addr(SB) + (unsigned)((8 * g + q4) * 288 + p4 * 8);
#pragma unroll
        for (int ks = 0; ks < 4; ++ks) { s16x4 lo[8], hi[8]; tr_frags8<4 * 288>(lo, hi, sa + ks * 32 * 288);
#pragma unroll
            for (int e = 0; e < 8; ++e) cb[e] = MFMA16(FRAG8(lo, hi, e), qf[ks], cb[e]); }
    }
    bf16* BR = (bf16*)(F.ws + WS_BUFB);
    {
        const int i = 16 * w + n; const float wf = __expf(lgf * (float)(i + 1)), wb = __expf(lgb * (float)(128 - i));
        float ss = 0.f;
#pragma unroll
        for (int e = 0; e < 8; ++e) { o[e] = o[e] + wf * cf[e] + wb * cb[e]; ss += (o[e][0] * o[e][0] + o[e][1] * o[e][1]) + (o[e][2] * o[e][2] + o[e][3] * o[e][3]); }
        ss += __shfl_xor(ss, 16); ss += __shfl_xor(ss, 32);
        const float rstd = __builtin_amdgcn_rsqf(ss * (1.f / GD) + EPS); const size_t row = (size_t)(row0 + i);
        u32x2 gw[8];
#pragma unroll
        for (int e = 0; e < 8; ++e) gw[e] = *(const u32x2*)(P + row * INW + G_OFF + h * GD + 16 * e + 4 * g);
#pragma unroll
        for (int e = 0; e < 8; ++e) { u32x2 ov; ov.x = pk2(bflo(gw[e].x) * o[e][0] * rstd, bfhi(gw[e].x) * o[e][1] * rstd); ov.y = pk2(bflo(gw[e].y) * o[e][2] * rstd, bfhi(gw[e].y) * o[e][3] * rstd);
            *(u32x2*)(BR + row * DM + h * GD + 16 * e + 4 * g) = ov; }
    }
}

constexpr int DFTM_LDS = 0, ZS_LDS = 69632;
__device__ __forceinline__ void chdft_stage_m(Frame& F) {
    const bf16* M = (const bf16*)(F.ws + WS_TAB + 65536); LAS bf16* MS = (LAS bf16*)(F.lds + DFTM_LDS);
    __syncthreads();
#pragma unroll
    for (int i = 0; i < 8; ++i) { const int idx = F.tid + 512 * i, row = idx >> 4, ch = idx & 15; *(LAS u32x4*)(MS + row * 136 + ch * 8) = *(const u32x4*)(M + row * GD + ch * 8); }
    __syncthreads();
}
constexpr int ZP_LDS = 69632, ZM_LDS = 69632 + 34816, SPC_LDS = 69632 + 2 * 34816;
__device__ __forceinline__ void chdft_ctx_item(Frame& F, int r) {
    const int b = r >> 3, g_ = (r >> 1) & 3, ci = r & 1;
    const bf16* P = (const bf16*)(F.ws + WS_PROJ); const int row0 = chunk_row(b, ci);
    LAS bf16* MS = (LAS bf16*)(F.lds + DFTM_LDS); LAS bf16* ZS = (LAS bf16*)(F.lds + ZS_LDS);
    int tid_ = F.tid; asm volatile("" : "+v"(tid_));
    __syncthreads();
    load_tile_p<136>(ZS, P + (size_t)row0 * INW + F_OFF + g_ * GD, INW, tid_);
    __syncthreads();
    const int lane = tid_ & 63, w = F.wave, g = lane >> 4, n = lane & 15;
    bf16x8 zf[4];
#pragma unroll
    for (int ks = 0; ks < 4; ++ks) zf[ks] = *(const LAS bf16x8*)(ZS + (16 * w + n) * 136 + 32 * ks + 8 * g);
    const int t0 = ci * 128, T = CTXL;
    bf16* Z = (bf16*)(F.ws + WS_ZCT) + (size_t)NB * 512 * 8192;
#pragma unroll
    for (int half = 0; half < 2; ++half) {
        f32x4 acc[8];
#pragma unroll
        for (int ct = 0; ct < 8; ++ct) { acc[ct] = (f32x4){0.f, 0.f, 0.f, 0.f};
#pragma unroll
            for (int ks = 0; ks < 4; ++ks) { const bf16x8 mf = *(const LAS bf16x8*)(MS + (128 * half + 16 * ct + n) * 136 + 32 * ks + 8 * g); acc[ct] = MFMA16(zf[ks], mf, acc[ct]); } }
#pragma unroll
        for (int ct = 0; ct < 8; ++ct) { const int cp = g_ * GD + 16 * ct + n; bf16* dst = Z + ((size_t)(b * 512 + cp) * 2 + half) * T + t0 + 16 * w + 4 * g;
            u32x2 o; o.x = pk2(acc[ct][0], acc[ct][1]); o.y = pk2(acc[ct][2], acc[ct][3]); *(u32x2*)dst = o; }
    }
}

struct DsRegs { u32x4 k[4], v[4]; };
__device__ __forceinline__ void ds_load(Frame& F, int it, DsRegs& R) {
    int b, h, ci; decode_item(it, false, b, h, ci);
    int tid_ = F.tid; asm volatile("" : "+v"(tid_));
    const bf16* P = (const bf16*)(F.ws + WS_PROJ) + (size_t)chunk_row(b, ci) * INW + h * GD;
#pragma unroll
    for (int i = 0; i < 4; ++i) { const int idx = tid_ + 512 * i, row = idx >> 4, ch = idx & 15; R.k[i] = *(const u32x4*)(P + (size_t)row * INW + K_OFF + ch * 8); R.v[i] = *(const u32x4*)(P + (size_t)row * INW + V_OFF + ch * 8); }
}
__device__ __forceinline__ void ds_stage(Frame& F, int l, int it, const DsRegs& R) {
    int b, h, ci; decode_item(it, false, b, h, ci);
    int tid_ = F.tid; asm volatile("" : "+v"(tid_));
    LAS bf16* KS = (LAS bf16*)F.lds; LAS bf16* VF = (LAS bf16*)(F.lds + 36864); LAS bf16* VB = (LAS bf16*)(F.lds + 73728);
    const float lgf = F.in[8][(l * 2 + 0) * NGRP + h], lgb = F.in[8][(l * 2 + 1) * NGRP + h];
#pragma unroll
    for (int i = 0; i < 4; ++i) { const int idx = tid_ + 512 * i, row = idx >> 4, ch = idx & 15; const u32x4 v = R.v[i];
        *(LAS u32x4*)(KS + row * 144 + ch * 8) = R.k[i];
        const float wf = __expf(lgf * (float)(127 - row)), wb = __expf(lgb * (float)row);
        const float x[8] = {bflo(v.x), bfhi(v.x), bflo(v.y), bfhi(v.y), bflo(v.z), bfhi(v.z), bflo(v.w), bfhi(v.w)};
        u32x4 a, c; a.x = pk2(x[0] * wf, x[1] * wf); a.y = pk2(x[2] * wf, x[3] * wf); a.z = pk2(x[4] * wf, x[5] * wf); a.w = pk2(x[6] * wf, x[7] * wf);
        c.x = pk2(x[0] * wb, x[1] * wb); c.y = pk2(x[2] * wb, x[3] * wb); c.z = pk2(x[4] * wb, x[5] * wb); c.w = pk2(x[6] * wb, x[7] * wb);
        *(LAS u32x4*)(VF + row * 144 + ch * 8) = a; *(LAS u32x4*)(VB + row * 144 + ch * 8) = c; }
}
__device__ __forceinline__ void ds_compute(Frame& F, int it) {
    int b, h, ci; decode_item(it, false, b, h, ci);
    int lane_ = F.lane; asm volatile("" : "+v"(lane_));
    LAS bf16* KS = (LAS bf16*)F.lds; LAS bf16* VF = (LAS bf16*)(F.lds + 36864); LAS bf16* VB = (LAS bf16*)(F.lds + 73728);
    const int lane = lane_, w = F.wave, g = lane >> 4, n = lane & 15, q4 = n >> 2, p4 = n & 3;
    f32x4 af[8], ab[8];
#pragma unroll
    for (int e = 0; e < 8; ++e) { af[e] = (f32x4){0.f, 0.f, 0.f, 0.f}; ab[e] = af[e]; }
    const unsigned ka = lds_addr(KS) + (unsigned)((8 * g + q4) * 288 + (16 * w + 4 * p4) * 2);
    const unsigned fa = lds_addr(VF) + (unsigned)((8 * g + q4) * 288 + p4 * 8), ba = lds_addr(VB) + (unsigned)((8 * g + q4) * 288 + p4 * 8);
#pragma unroll
    for (int ks = 0; ks < 4; ++ks) {
        s16x4 klo, khi; tr_pair<0, 4 * 288>(klo, khi, ka + ks * 32 * 288);
        { s16x4 lo[8], hi[8]; tr_frags8<4 * 288>(lo, hi, fa + ks * 32 * 288); const bf16x8 kf = __builtin_shufflevector(klo, khi, 0, 1, 2, 3, 4, 5, 6, 7);
#pragma unroll
          for (int e = 0; e < 8; ++e) af[e] = MFMA16(FRAG8(lo, hi, e), kf, af[e]); }
        { s16x4 lo[8], hi[8]; tr_frags8<4 * 288>(lo, hi, ba + ks * 32 * 288); const bf16x8 kf = __builtin_shufflevector(klo, khi, 0, 1, 2, 3, 4, 5, 6, 7);
#pragma unroll
          for (int e = 0; e < 8; ++e) ab[e] = MFMA16(FRAG8(lo, hi, e), kf, ab[e]); }
    }
    bf16* DS = (bf16*)(F.ws + WS_BUFA);
    bf16* df = DS + ((size_t)(((b * NGRP + h) * 2 + 0) * NCH + ci)) * (GD * GD); bf16* db = df + (size_t)NCH * GD * GD;
#pragma unroll
    for (int e = 0; e < 8; ++e) { const int o = (16 * w + n) * GD + 16 * e + 4 * g;
        u32x2 x, y; x.x = pk2(af[e][0], af[e][1]); x.y = pk2(af[e][2], af[e][3]); y.x = pk2(ab[e][0], ab[e][1]); y.y = pk2(ab[e][2], ab[e][3]);
        *(u32x2*)(df + o) = x; *(u32x2*)(db + o) = y; }
}
__device__ __forceinline__ void ds_pipeline(Frame& F, int l) {
    DsRegs R; int it = F.c; if (it < 1088) ds_load(F, it, R);
    while (it < 1088) {
        __syncthreads(); ds_stage(F, l, it, R); __syncthreads();
        const int nit = it + F.G; if (nit < 1088) ds_load(F, nit, R);
        ds_compute(F, it); it = nit;
    }
}
struct SguRegs { u32x4 v[4]; u32x2 u[8]; };
__device__ __forceinline__ void sgu_decode(int it, bool lat_only, int& b, int& g_, int& ci) { g_ = it & 3; const int r = it >> 2; if (lat_only) { b = r >> 5; ci = 2 + (r & 31); } else { b = r / NCH; ci = r % NCH; } }
__device__ __forceinline__ void sgu_load(Frame& F, int it, bool lat_only, SguRegs& R) {
    int b, g_, ci; sgu_decode(it, lat_only, b, g_, ci);
    int tid_ = F.tid; asm volatile("" : "+v"(tid_));
    const bf16* P = (const bf16*)(F.ws + WS_PROJ) + (size_t)chunk_row(b, ci) * INW + g_ * GD;
    { const int p = tid_ >> 2, qd = tid_ & 3; const bf16* src = P + (size_t)p * INW + VS_OFF + qd * 32;
#pragma unroll
      for (int i = 0; i < 4; ++i) R.v[i] = *(const u32x4*)(src + 8 * i); }
    { const int lane = tid_ & 63, g = lane >> 4, n = lane & 15; const bf16* src = P + (size_t)(16 * F.wave + n) * INW + U_OFF + 4 * g;
#pragma unroll
      for (int e = 0; e < 8; ++e) R.u[e] = *(const u32x2*)(src + 16 * e); }
}
__device__ __forceinline__ void sgu_stage_w(Frame& F, int l, int g_) {
    int tid_ = F.tid; asm volatile("" : "+v"(tid_));
    LAS bf16* WSM = (LAS bf16*)F.lds; const float* wsg = F.in[10] + (size_t)(l * NGRP + g_) * GD * GD;
#pragma unroll
    for (int i = 0; i < 8; ++i) { const int idx = tid_ + 512 * i, row = idx >> 5, ch = idx & 31; const f32x4 v = *(const f32x4*)(wsg + row * GD + ch * 4);
        u32x2 o; o.x = pk2(v[0], v[1]); o.y = pk2(v[2], v[3]); *(LAS u32x2*)(WSM + row * 136 + ch * 4) = o; }
}
__device__ __forceinline__ void sgu_stage(Frame& F, const SguRegs& R) {
    int tid_ = F.tid; asm volatile("" : "+v"(tid_));
    LAS bf16* VN = (LAS bf16*)(F.lds + 34816);
    const int p = tid_ >> 2, qd = tid_ & 3;
    float x[32];
#pragma unroll
    for (int i = 0; i < 4; ++i) { const u32x4 w = R.v[i]; x[8 * i] = bflo(w.x); x[8 * i + 1] = bfhi(w.x); x[8 * i + 2] = bflo(w.y); x[8 * i + 3] = bfhi(w.y); x[8 * i + 4] = bflo(w.z); x[8 * i + 5] = bfhi(w.z); x[8 * i + 6] = bflo(w.w); x[8 * i + 7] = bfhi(w.w); }
    float s = 0.f;
#pragma unroll
    for (int i = 0; i < 32; ++i) s += x[i];
    s += __shfl_xor(s, 1); s += __shfl_xor(s, 2); const float mu = s * (1.f / GD); float q = 0.f;
#pragma unroll
    for (int i = 0; i < 32; ++i) { x[i] -= mu; q += x[i] * x[i]; }
    q += __shfl_xor(q, 1); q += __shfl_xor(q, 2); const float rstd = __builtin_amdgcn_rsqf(q * (1.f / GD) + EPS);
#pragma unroll
    for (int i = 0; i < 4; ++i) { u32x4 o; o.x = pk2(x[8 * i] * rstd, x[8 * i + 1] * rstd); o.y = pk2(x[8 * i + 2] * rstd, x[8 * i + 3] * rstd); o.z = pk2(x[8 * i + 4] * rstd, x[8 * i + 5] * rstd); o.w = pk2(x[8 * i + 6] * rstd, x[8 * i + 7] * rstd);
        *(LAS u32x4*)(VN + p * 144 + qd * 32 + 8 * i) = o; }
}
__device__ __forceinline__ void sgu_compute(Frame& F, int l, int it, bool lat_only, const u32x2 (&uw)[8]) {
    int b, g_, ci; sgu_decode(it, lat_only, b, g_, ci);
    int lane_ = F.lane; asm volatile("" : "+v"(lane_));
    LAS bf16* WSM = (LAS bf16*)F.lds; LAS bf16* VN = (LAS bf16*)(F.lds + 34816);
    const int lane = lane_, w = F.wave, g = lane >> 4, n = lane & 15, q4 = n >> 2, p4 = n & 3;
    f32x4 acc[8];
#pragma unroll
    for (int e = 0; e < 8; ++e) acc[e] = (f32x4){0.f, 0.f, 0.f, 0.f};
    const unsigned va = lds_addr(VN) + (unsigned)((8 * g + q4) * 288 + p4 * 8);
#pragma unroll
    for (int ks = 0; ks < 4; ++ks) { const bf16x8 wf = *(const LAS bf16x8*)(WSM + (16 * w + n) * 136 + 32 * ks + 8 * g);
        s16x4 lo[8], hi[8]; tr_frags8<4 * 288>(lo, hi, va + ks * 32 * 288);
#pragma unroll
        for (int e = 0; e < 8; ++e) acc[e] = MFMA16(FRAG8(lo, hi, e), wf, acc[e]); }
    bf16* BR = (bf16*)(F.ws + WS_BUFB);
    const int q = 16 * w + n; const float bs = F.in[11][(l * NGRP + g_) * GD + q]; const size_t row = (size_t)(chunk_row(b, ci) + q);
#pragma unroll
    for (int e = 0; e < 8; ++e) { u32x2 ov; ov.x = pk2(bflo(uw[e].x) * (acc[e][0] + bs), bfhi(uw[e].x) * (acc[e][1] + bs)); ov.y = pk2(bflo(uw[e].y) * (acc[e][2] + bs), bfhi(uw[e].y) * (acc[e][3] + bs));
        *(u32x2*)(BR + row * DM + 2 * MIXW + g_ * GD + 16 * e + 4 * g) = ov; }
}
__device__ __forceinline__ void sgu_pipeline(Frame& F, int l, bool lat_only) {
    const int nit_all = lat_only ? 1024 : 1088;
    SguRegs R; int it = (F.c + 64) % F.G, wg = -1; if (it < nit_all) sgu_load(F, it, lat_only, R);
    while (it < nit_all) {
        __syncthreads();
        if ((it & 3) != wg) { wg = it & 3; sgu_stage_w(F, l, wg); }
        sgu_stage(F, R);
        u32x2 uw[8];
#pragma unroll
        for (int e = 0; e < 8; ++e) uw[e] = R.u[e];
        __syncthreads();
        const int nit = it + F.G; if (nit < nit_all) sgu_load(F, nit, lat_only, R);
        sgu_compute(F, l, it, lat_only, uw); it = nit;
    }
}
struct CdRegs { u32x4 a[4], m[4]; };
__device__ __forceinline__ void cd_load(Frame& F, int it, CdRegs& R) {
    const int b = it >> 6, g_ = (it >> 4) & 3, t0 = 128 * (it & 15);
    int tid_ = F.tid; asm volatile("" : "+v"(tid_));
    const bf16* P = (const bf16*)(F.ws + WS_PROJ) + (size_t)(b * SEQ) * INW + F_OFF + g_ * GD;
#pragma unroll
    for (int i = 0; i < 4; ++i) { const int idx = tid_ + 512 * i, row = idx >> 4, ch = idx & 15; const int t = t0 + row;
        R.a[i] = *(const u32x4*)(P + (size_t)t * INW + ch * 8);
        R.m[i] = (u32x4){0u, 0u, 0u, 0u}; if (t > 0) R.m[i] = *(const u32x4*)(P + (size_t)(SEQ - t) * INW + ch * 8); }
}
__device__ __forceinline__ void cd_stage(Frame& F, int it, const CdRegs& R) {
    const int b = it >> 6, g_ = (it >> 4) & 3, np = it & 15;
    int tid_ = F.tid; asm volatile("" : "+v"(tid_));
    LAS bf16* MS = (LAS bf16*)(F.lds + DFTM_LDS); LAS bf16* ZP = (LAS bf16*)(F.lds + ZP_LDS); LAS bf16* ZM = (LAS bf16*)(F.lds + ZM_LDS); LAS float* SPC = (LAS float*)(F.lds + SPC_LDS);
#pragma unroll
    for (int i = 0; i < 4; ++i) { const int idx = tid_ + 512 * i, row = idx >> 4, ch = idx & 15; const u32x4 a = R.a[i], m = R.m[i];
        u32x4 sp, sm;
        sp.x = pk2(bflo(a.x) + bflo(m.x), bfhi(a.x) + bfhi(m.x)); sp.y = pk2(bflo(a.y) + bflo(m.y), bfhi(a.y) + bfhi(m.y)); sp.z = pk2(bflo(a.z) + bflo(m.z), bfhi(a.z) + bfhi(m.z)); sp.w = pk2(bflo(a.w) + bflo(m.w), bfhi(a.w) + bfhi(m.w));
        sm.x = pk2(bflo(a.x) - bflo(m.x), bfhi(a.x) - bfhi(m.x)); sm.y = pk2(bflo(a.y) - bflo(m.y), bfhi(a.y) - bfhi(m.y)); sm.z = pk2(bflo(a.z) - bflo(m.z), bfhi(a.z) - bfhi(m.z)); sm.w = pk2(bflo(a.w) - bflo(m.w), bfhi(a.w) - bfhi(m.w));
        *(LAS u32x4*)(ZP + row * 136 + ch * 8) = sp; *(LAS u32x4*)(ZM + row * 136 + ch * 8) = sm; }
    if (np == 0 && tid_ < 128) { const bf16* zr = (const bf16*)(F.ws + WS_PROJ) + (size_t)(b * SEQ + SEQ / 2) * INW + F_OFF + g_ * GD; float acc = 0.f;
        for (int c = 0; c < 128; ++c) acc += bf1(zr[c]) * bf1(MS[tid_ * 136 + c]);
        SPC[tid_] = acc; }
}
__device__ __forceinline__ void cd_compute(Frame& F, int it) {
    const int b = it >> 6, g_ = (it >> 4) & 3, np = it & 15, t0 = 128 * np;
    int lane_ = F.lane; asm volatile("" : "+v"(lane_));
    LAS bf16* MS = (LAS bf16*)(F.lds + DFTM_LDS); LAS bf16* ZP = (LAS bf16*)(F.lds + ZP_LDS); LAS bf16* ZM = (LAS bf16*)(F.lds + ZM_LDS); LAS float* SPC = (LAS float*)(F.lds + SPC_LDS);
    const int lane = lane_, w = F.wave, g = lane >> 4, n = lane & 15;
    bf16* Z = (bf16*)(F.ws + WS_ZCT);
#pragma unroll
    for (int half = 0; half < 2; ++half) {
        const LAS bf16* ZT = half ? ZM : ZP;
        bf16x8 zf[4];
#pragma unroll
        for (int ks = 0; ks < 4; ++ks) zf[ks] = *(const LAS bf16x8*)(ZT + (16 * w + n) * 136 + 32 * ks + 8 * g);
        f32x4 acc[8];
#pragma unroll
        for (int ct = 0; ct < 8; ++ct) { acc[ct] = (f32x4){0.f, 0.f, 0.f, 0.f};
#pragma unroll
            for (int ks = 0; ks < 4; ++ks) { const bf16x8 mf = *(const LAS bf16x8*)(MS + (128 * half + 16 * ct + n) * 136 + 32 * ks + 8 * g); acc[ct] = MFMA16(zf[ks], mf, acc[ct]); } }
#pragma unroll
        for (int ct = 0; ct < 8; ++ct) { const int cp = g_ * GD + 16 * ct + n;
            if (half == 1 && np == 0 && w == 0 && g == 0) acc[ct][0] = SPC[16 * ct + n];
            bf16* dst = Z + (size_t)(b * 512 + cp) * 4096 + half * 2048 + t0 + 16 * w + 4 * g;
            u32x2 o; o.x = pk2(acc[ct][0], acc[ct][1]); o.y = pk2(acc[ct][2], acc[ct][3]); *(u32x2*)dst = o; }
    }
}
__device__ __forceinline__ void cd_pipeline(Frame& F) {
    CdRegs R; int it = (F.c + 128) % F.G; if (it < 512) cd_load(F, it, R);
    while (it < 512) {
        __syncthreads(); cd_stage(F, it, R); __syncthreads();
        const int nit = it + F.G; if (nit < 512) cd_load(F, nit, R);
        cd_compute(F, it); it = nit;
    }
}

struct Args { const float* in[16]; float* out; unsigned char* ws; int ph_lo, ph_hi; };
__global__ void __launch_bounds__(NTHR, 2) fwd_kernel(Args args) {
    extern __shared__ __attribute__((aligned(16))) unsigned char lds_raw[];
    Frame F;
    F.lds = (LAS unsigned char*)lds_raw;
    F.tid = threadIdx.x; F.lane = F.tid & 63; { int w_ = __builtin_amdgcn_readfirstlane(F.tid >> 6); asm volatile("" : "+s"(w_)); F.wave = w_; }
    F.G = gridDim.x; F.c = blockIdx.x; F.ws = args.ws; F.out = args.out;
    volatile LAS unsigned* MISC = (volatile LAS unsigned*)(F.lds + MISC_OFF);
    for (int u = F.tid; u < (LDS_BYTES - MISC_OFF) / 4; u += NTHR) MISC[u] = 0u;
    __syncthreads();
    unsigned* ctl = (unsigned*)(F.ws + WS_CTL);
    (void)xcd_barrier_post(ctl + CW_BAR, MISC + 8);
#if MK_PER_PHASE_LAUNCH
    const int lo = args.ph_lo, hi = args.ph_hi;
    int ph = 0;
#endif
#if MK_PER_PHASE_LAUNCH
#define PH_ON (ph >= lo && ph < hi)
#define PH_END do { if (ph >= lo && ph + 1 < hi) { XcdBarrier b_; b_.x = xb_xcc_id(); b_.st = (volatile LAS unsigned*)(F.lds + MISC_OFF) + 8; b_.bar = (unsigned*)(F.ws + WS_CTL) + CW_BAR; xcd_barrier(b_, F.wave == 0 && (int)__builtin_amdgcn_mbcnt_hi(~0u, __builtin_amdgcn_mbcnt_lo(~0u, 0u)) == 0); } ++ph; } while (0)
#define PH_END_LAST PH_END
#else
#define PH_ON true
#define PH_END do { XcdBarrier b_; b_.x = xb_xcc_id(); b_.st = (volatile LAS unsigned*)(F.lds + MISC_OFF) + 8; b_.bar = (unsigned*)(F.ws + WS_CTL) + CW_BAR; xcd_barrier(b_, F.wave == 0 && (int)__builtin_amdgcn_mbcnt_hi(~0u, __builtin_amdgcn_mbcnt_lo(~0u, 0u)) == 0); } while (0)
#define PH_END_LAST do { } while (0)
#endif
#define PH_TID do { unsigned m_ = ~0u; asm volatile("" : "+s"(m_)); int l_ = (int)__builtin_amdgcn_mbcnt_hi(m_, __builtin_amdgcn_mbcnt_lo(m_, 0u)); F.lane = l_; F.tid = F.wave * 64 + l_; { int c_ = blockIdx.x, g_ = gridDim.x; asm volatile("" : "+s"(c_), "+s"(g_)); F.c = c_; F.G = g_; } const __attribute__((address_space(4))) Args* ap_ = (const __attribute__((address_space(4))) Args*)__builtin_amdgcn_kernarg_segment_ptr(); asm volatile("" : "+s"(ap_)); F.ws = ap_->ws; F.out = ap_->out; _Pragma("unroll") for (int i_ = 0; i_ < 16; ++i_) F.in[i_] = ap_->in[i_]; } while (0)
#define REPS(k) for (int rep_ = 0; rep_ < 1 + ((PROBE_REP >> (k)) & 1); ++rep_)
#define REP_SYNC(k) do { if (rep_ == 1) { XcdBarrier b_; b_.x = xb_xcc_id(); b_.st = (volatile LAS unsigned*)(F.lds + MISC_OFF) + 8; b_.bar = (unsigned*)(F.ws + WS_CTL) + CW_BAR; xcd_barrier(b_, F.wave == 0 && (int)__builtin_amdgcn_mbcnt_hi(~0u, __builtin_amdgcn_mbcnt_lo(~0u, 0u)) == 0); } } while (0)
    LAS unsigned char* ring = F.lds;
#define WIN ((bf16*)(F.ws + WS_WIN))
#define WBR ((bf16*)(F.ws + WS_WBR))
#define WOUT ((bf16*)(F.ws + WS_WOUT))
#define W1 ((bf16*)(F.ws + WS_W1))
#define W2 ((bf16*)(F.ws + WS_W2))
#define BUFA ((bf16*)(F.ws + WS_BUFA))
#define BUFB ((bf16*)(F.ws + WS_BUFB))
#define PROJ ((bf16*)(F.ws + WS_PROJ))
#define XC ((float*)(F.ws + WS_XC))
#define normg (F.in[6])

    if (PH_ON) REPS(0) { REP_SYNC(0); PH_TID; p0_body(F); }
    PH_END;
    if (PH_ON) REPS(0) { REP_SYNC(0); PH_TID; p0b_body(F); }
    PH_END;
    if (PH_ON) REPS(0) { REP_SYNC(0); PH_TID; RowPass P{}; P.xl_in = F.in[0]; P.xc_in = F.in[2]; P.xl_out = nullptr; P.xc_out = nullptr; P.Y = nullptr; P.gy = nullptr; P.gate_off = 0;
        P.gx = normg + 0 * DM; P.shift_off = 0; P.scale_off = DM; P.lnext = 0; P.l = 0; P.do_ctx = true; P.HX = BUFA; P.HX8 = F.ws + WS_HX8; row_pass(F, P); }
    PH_END;

    for (int l = 0; l < DEPTH; ++l) {
        const bool last = (l == DEPTH - 1);
        if (PH_ON) REPS(1) { REP_SYNC(1); PH_TID;
            {
                pg8::Gemm g{DM, DM, DM}; TileSched<GATE_OFF / 256> S; S.init(last ? 2 : 0, last ? 4 : GATE_OFF / 256, F.G, F.c, BUFA, (size_t)256 * DM * 2, WIN, (size_t)256 * DM * 2, DM / 64);
                EpiProj E{PROJ, (const float*)(F.ws + WS_TAB), 1.f};
                pg8::gemm_phase<EpiProj, TileSched<GATE_OFF / 256>, true, true, false, false, true>(ring, g, S, E, F.wave); }
            {
                pg8::Gemm g{DM / 2, DM / 2, DM / 2}; TileSched<(INW - GATE_OFF) / 256> S; S.init(0, last ? 0 : (INW - GATE_OFF) / 256, F.G, F.c, F.ws + WS_HX8, (size_t)256 * DM, F.ws + WS_WIN + (size_t)GATE_OFF * DM * 2, (size_t)256 * DM, DM / 128, 1, GATE_OFF);
                EpiProj E{PROJ, (const float*)(F.ws + WS_TAB), 0.015625f};
                pg8::gemm_phase<EpiProj, TileSched<(INW - GATE_OFF) / 256>, true, true, false, true, true>(ring, g, S, E, F.wave); }
            if (l == 0 && F.G == 256 && F.c >= 160) convert_weights(F, 0, CV_WIN, CV_WIN + 4 * CV_BR1 + CV_WO, 160, 96); }
        PH_END;
        if (PH_ON) REPS(2) { REP_SYNC(2); PH_TID;
            const int nmix = last ? 1024 : 1088;
            (void)nmix;
            ds_pipeline(F, l);
            sgu_pipeline(F, l, last);
            chdft_stage_m(F);
            cd_pipeline(F);
            if (!last) for (int it = (F.c + 192) % F.G; it < 64; it += F.G) chdft_ctx_item(F, it);
            conv_body(F, l, last ? RL : RT);
            __syncthreads();
        }
        PH_END;
        if (PH_ON) REPS(3) { REP_SYNC(3); PH_TID;
            scan_body(F, l);
            if (!last) { pg8::Gemm g{512, 512, 512}; DftSchedC S{F.G, F.c, (const char*)(F.ws + WS_DFTC), (const char*)(F.ws + WS_ZCT + 64 * MiB)};
                EpiPlain E{BUFB, DM, 0.005524271728019903f, nullptr};
                pg8::gemm_phase<EpiPlain, DftSchedC, false, true>(ring, g, S, E, F.wave); }
            { pg8::Gemm g{4096, 4096, 4096}; DftSchedL S{F.G, F.c, (const char*)(F.ws + WS_DFTL), (const char*)(F.ws + WS_ZCT)};
                EpiPlain E{BUFB, DM, 0.001381067932004976f, nullptr};
                pg8::gemm_phase<EpiPlain, DftSchedL, false, true>(ring, g, S, E, F.wave); }
        }
        PH_END;
        if (PH_ON) REPS(4) { REP_SYNC(4); PH_TID; const int nmix = last ? 1024 : 1088; for (int it = (F.c + 192) % F.G; it < nmix; it += F.G) ret_item_mfma(F, l, it, last); __syncthreads(); }
        PH_END;
        if (PH_ON) REPS(5) { REP_SYNC(5); PH_TID; pg8::Gemm g{DM, MIXW, MIXW}; const int nM = last ? 128 : 136; YSched S{nM, nM * 8, F.G, F.c, (const char*)BUFB, (const char*)WBR};
            EpiMerge E{PROJ, BUFA};
            pg8::gemm_phase<EpiMerge, YSched, true, true, false, false, true>(ring, g, S, E, F.wave);
            if (!last && F.G == 256 && F.c >= 64) convert_weights(F, l + 1, 0, CV_WIN, 64, 192);
            if (l == 0 && F.G == 256 && F.c >= 64) convert_weights(F, 0, CV_WIN + 4 * CV_BR1 + CV_WO, CV_WIN + 4 * CV_BR1 + CV_WO + CV_W1, 64, 192); }
        PH_END;
        if (PH_ON) REPS(6) { REP_SYNC(6); PH_TID; pg8::Gemm g{DM, DM, DM}; TileSched<8> S; S.init(0, last ? 0 : 8, F.G, F.c, BUFA, (size_t)256 * DM * 2, WOUT, (size_t)256 * DM * 2, DM / 64, 4, 0, 2048, 2048);
            EpiPlainFL E{BUFB, DM, 1.f, (float*)(F.ws + WS_ZCT)};
            pg8::gemm_phase<EpiPlainFL, TileSched<8>, true, true, false, false, true, true>(ring, g, S, E, F.wave); }
        PH_END;
        if (PH_ON) { PH_TID; RowPass P{}; P.xl_in = (l == 0) ? F.in[0] : (const float*)F.out; P.xc_in = (l == 0) ? F.in[2] : (const float*)XC; P.xl_out = nullptr; P.xc_out = XC; P.Y = BUFB;
            P.gy = normg + (size_t)(l * 4 + 1) * DM; P.gate_off = 2 * DM; P.gx = normg + (size_t)(l * 4 + 2) * DM; P.shift_off = 3 * DM; P.scale_off = 4 * DM; P.lnext = l; P.l = l; P.do_ctx = !last; P.HX = BUFA; P.part = (const float*)(F.ws + WS_ZCT);
            row_pass(F, P); }
        PH_END;
        if (PH_ON) REPS(8) { REP_SYNC(8); PH_TID; pg8::Gemm g{DM, DM, DM}; TileSched<2 * DFF / 256> S; S.init(0, last ? 0 : 2 * DFF / 256, F.G, F.c, BUFA, (size_t)256 * DM * 2, W1, (size_t)256 * DM * 2, DM / 64);
            EpiSwiglu E{PROJ};
            pg8::gemm_phase<EpiSwiglu, TileSched<2 * DFF / 256>, true, true, false, false, true>(ring, g, S, E, F.wave);
            if (l == 0 && F.G == 256 && F.c >= 96) convert_weights(F, 0, CV_WIN + 4 * CV_BR1 + CV_WO + CV_W1, CV_TOTAL, 96, 160);
            if (!last && F.G == 256 && F.c >= 96) convert_weights(F, l + 1, CV_WIN, CV_WIN + 4 * CV_BR1 + CV_WO, 96, 160); }
        PH_END;
        if (PH_ON) REPS(9) { REP_SYNC(9); PH_TID; pg8::Gemm g{DFF, DFF, DFF}; TileSched<8> S; S.init(0, last ? 0 : 8, F.G, F.c, PROJ, (size_t)256 * DFF * 2, W2, (size_t)256 * DFF * 2, DFF / 64, 4, 0, 2048, 2048);
            EpiPlainFL E{BUFA, DM, 1.f, (float*)(F.ws + WS_ZCT)};
            pg8::gemm_phase<EpiPlainFL, TileSched<8>, true, true, false, false, true, true>(ring, g, S, E, F.wave); }
        PH_END;
        if (PH_ON) { PH_TID; RowPass P{}; P.xl_in = (l == 0) ? F.in[0] : (const float*)F.out; P.xc_in = XC; P.xl_out = F.out; P.xc_out = XC; P.Y = BUFA;
            P.Y0 = BUFB; P.gy0 = normg + (size_t)(l * 4 + 1) * DM; P.gate0_off = 2 * DM;
            P.gy = normg + (size_t)(l * 4 + 3) * DM; P.gate_off = 5 * DM; P.gx = last ? nullptr : normg + (size_t)((l + 1) * 4 + 0) * DM; P.shift_off = 0; P.scale_off = DM; P.lnext = last ? -1 : l + 1; P.l = l; P.do_ctx = !last; P.HX = BUFA; P.HX8 = F.ws + WS_HX8; P.part = (const float*)(F.ws + WS_ZCT);
            row_pass(F, P);
            if (!last) convert_weights(F, l + 1, F.G == 256 ? CV_WIN + 4 * CV_BR1 + CV_WO : 0, CV_TOTAL, 0, F.G); }
        if (!last) PH_END; else PH_END_LAST;
    }
#undef PH_ON
#undef PH_END
#undef PH_END_LAST
#undef WIN
#undef WBR
#undef WOUT
#undef W1
#undef W2
#undef BUFA
#undef BUFB
#undef PROJ
#undef XC
#undef normg
}

constexpr int N_PHASES = 3 + DEPTH * 10;
extern "C" void kernel_launch(void* const* d_in, const int* in_sizes, int n_in, void* d_out, int out_size, void* d_ws, size_t ws_size, hipStream_t stream) {
    static int grid = 0;
    if (grid == 0) {
        if (n_in != 16 || out_size != RL * DM || ws_size < WS_END) { fprintf(stderr, "kernel_launch: unexpected shapes (n_in %d, out %d, ws %zu < %zu); nothing launched\n", n_in, out_size, ws_size, (size_t)WS_END); grid = -1; return; }
        int dev = 0, cus = 0, per_cu = 0;
        if (hipGetDevice(&dev) != hipSuccess || hipDeviceGetAttribute(&cus, hipDeviceAttributeMultiprocessorCount, dev) != hipSuccess) { grid = -1; return; }
        if (hipFuncSetAttribute((const void*)fwd_kernel, hipFuncAttributeMaxDynamicSharedMemorySize, LDS_BYTES) != hipSuccess) { fprintf(stderr, "kernel_launch: hipFuncSetAttribute failed\n"); grid = -1; return; }
        if (hipOccupancyMaxActiveBlocksPerMultiprocessor(&per_cu, (const void*)fwd_kernel, NTHR, LDS_BYTES) != hipSuccess || per_cu < 1)
            fprintf(stderr, "kernel_launch: occupancy query reports %d workgroups per CU\n", per_cu);
        (void)hipGetLastError();
        grid = cus;
    }
    if (grid < 0) return;
    (void)in_sizes;
    if (hipMemsetAsync((char*)d_ws + WS_CTL, 0, CTL_ZERO_BYTES, stream) != hipSuccess) return;
    Args a{};
    for (int i = 0; i < 16; ++i) a.in[i] = (const float*)d_in[i];
    a.out = (float*)d_out; a.ws = (unsigned char*)d_ws;
#if MK_PER_PHASE_LAUNCH
    for (int p = 0; p < N_PHASES; ++p) { a.ph_lo = p; a.ph_hi = p + 1; hipLaunchKernelGGL(fwd_kernel, dim3(grid), dim3(NTHR), LDS_BYTES, stream, a); }
#else
    a.ph_lo = 0; a.ph_hi = N_PHASES;
    hipLaunchKernelGGL(fwd_kernel, dim3(grid), dim3(NTHR), LDS_BYTES, stream, a);
#endif
    const hipError_t le = hipPeekAtLastError();
    if (le != hipSuccess) fprintf(stderr, "kernel_launch: launch failed: %s\n", hipGetErrorName(le));
}
```
